# Optimizing an MI355X kernel written in HIP

```python
import math
import jax, jax.numpy as jnp
from jax import lax
import numpy as np

D_MODEL = 2048
BATCH = 4
SEQ = 8192
DEPTH = 1

CHUNK = 64
Q_BLOCK = 128
CONV_WIDTH = D_MODEL // 2
CONV_KERNEL = 31
HEAD_DIM = 128
V_HEAD_DIM = 2 * HEAD_DIM
N_HEADS = D_MODEL // (4 * HEAD_DIM)
ATTN_QK_WIDTH = N_HEADS * 2 * HEAD_DIM
ATTN_V_WIDTH = N_HEADS * V_HEAD_DIM
N_BRANCHES = 2
D_FF = 4 * D_MODEL
ROPE_THETA = 10000.0
EPS = 1e-6
IN_WIDTH = 2 * CONV_WIDTH + 2 * ATTN_QK_WIDTH + ATTN_V_WIDTH + N_BRANCHES * D_MODEL

kernel_name = "hybrid_conformer_diffattn_gated_block"


def rmsnorm(t, g):
    tf = t.astype(jnp.float32)
    y = tf * lax.rsqrt(jnp.mean(tf * tf, axis=-1, keepdims=True) + EPS)
    return (y * g.astype(jnp.float32)).astype(t.dtype)


def rope(t, cos, sin):
    half = t.shape[-1] // 2
    tf = t.astype(jnp.float32)
    t1, t2 = tf[..., :half], tf[..., half:]
    return jnp.concatenate([t1 * cos - t2 * sin, t2 * cos + t1 * sin], axis=-1).astype(t.dtype)


def lambda_init_fn(layer_idx):
    return 0.8 - 0.6 * math.exp(-0.3 * layer_idx)


def conformer_conv_branch(conv_a, conv_b_in, conv_w, conv_b, conv_norm_g, w_conv_out):
    glu = conv_a * jax.nn.sigmoid(conv_b_in)
    y = lax.conv_general_dilated(
        glu, conv_w[:, None, :].astype(glu.dtype), window_strides=(1,),
        padding=[(CONV_KERNEL - 1, 0)],
        dimension_numbers=("NWC", "WIO", "NWC"),
        feature_group_count=CONV_WIDTH) + conv_b
    y = jax.nn.silu(rmsnorm(y, conv_norm_g))
    return y @ w_conv_out


def diff_attention_branch(q, k, v, cos, sin, q_norm_g, k_norm_g,
                          lambda_q1, lambda_k1, lambda_q2, lambda_k2, subln_g, w_attn_out, lam_init):
    B, S, _ = q.shape
    nb = S // Q_BLOCK
    q = q.reshape(B, S, N_HEADS, 2, HEAD_DIM)
    k = k.reshape(B, S, N_HEADS, 2, HEAD_DIM)
    q = rope(rmsnorm(q, q_norm_g), cos, sin)
    k = rope(rmsnorm(k, k_norm_g), cos, sin)
    q = jnp.transpose(q, (0, 2, 3, 1, 4))
    k = jnp.transpose(k, (0, 2, 3, 1, 4))
    v = jnp.transpose(v.reshape(B, S, N_HEADS, V_HEAD_DIM), (0, 2, 1, 3))
    lam = (jnp.exp(jnp.sum(lambda_q1.astype(jnp.float32) * lambda_k1.astype(jnp.float32)))
           - jnp.exp(jnp.sum(lambda_q2.astype(jnp.float32) * lambda_k2.astype(jnp.float32)))
           + lam_init)
    scale = 1.0 / math.sqrt(HEAD_DIM)
    key_chunk = jnp.arange(S) // CHUNK
    q_blocks = jnp.moveaxis(q.reshape(B, N_HEADS, 2, nb, Q_BLOCK, HEAD_DIM), 3, 0)

    def attend(args):
        q_blk, blk = args
        s = jnp.einsum("bhmqd,bhmkd->bhmqk", q_blk, k).astype(jnp.float32) * scale
        q_chunk = (blk * Q_BLOCK + jnp.arange(Q_BLOCK)) // CHUNK
        mask = key_chunk[None, :] <= q_chunk[:, None]
        s = jnp.where(mask, s, jnp.finfo(jnp.float32).min)
        p = jax.nn.softmax(s, axis=-1)
        p_diff = p[:, :, 0] - lam * p[:, :, 1]
        return jnp.einsum("bhqk,bhkv->bhqv", p_diff.astype(v.dtype), v)

    out = lax.map(attend, (q_blocks, jnp.arange(nb)))
    out = jnp.moveaxis(out, 0, 2).reshape(B, N_HEADS, S, V_HEAD_DIM)
    out = rmsnorm(out, subln_g) * (1.0 - lam_init)
    out = jnp.transpose(out, (0, 2, 1, 3)).reshape(B, S, ATTN_V_WIDTH)
    return out @ w_attn_out


def setup_inputs(seed: int = 0) -> dict:
    key = jax.random.key(seed)
    ks = jax.random.split(key, 24)
    f32 = jnp.float32

    def nrm(k, shape, s):
        return jax.random.normal(k, shape, f32) * s

    def gain(k, shape):
        return 1.0 + 0.05 * jax.random.normal(k, shape, f32)

    L, D = DEPTH, D_MODEL
    pos_offset = jax.random.randint(ks[2], (BATCH, 1), 0, 1000, dtype=jnp.int32) * CHUNK
    return {
        "x": nrm(ks[0], (BATCH, SEQ, D), 1.0),
        "c": nrm(ks[1], (BATCH, D), 1.0),
        "pos": (pos_offset + jnp.arange(SEQ, dtype=jnp.int32)[None, :]).astype(jnp.int32),
        "ada_w": nrm(ks[3], (L, D, 6 * D), 0.5 * D ** -0.5),
        "ada_b": nrm(ks[4], (L, 6 * D), 0.01),
        "norm_mix_g": gain(ks[5], (L, D)),
        "w_in": nrm(ks[6], (L, D, IN_WIDTH), D ** -0.5),
        "conv_w": nrm(ks[7], (L, CONV_KERNEL, CONV_WIDTH), CONV_KERNEL ** -0.5),
        "conv_b": nrm(ks[8], (L, CONV_WIDTH), 0.01),
        "conv_norm_g": gain(ks[9], (L, CONV_WIDTH)),
        "w_conv_out": nrm(ks[10], (L, CONV_WIDTH, D), CONV_WIDTH ** -0.5),
        "q_norm_g": gain(ks[11], (L, HEAD_DIM)),
        "k_norm_g": gain(ks[12], (L, HEAD_DIM)),
        "lambda_q1": nrm(ks[13], (L, HEAD_DIM), 0.1),
        "lambda_k1": nrm(ks[14], (L, HEAD_DIM), 0.1),
        "lambda_q2": nrm(ks[15], (L, HEAD_DIM), 0.1),
        "lambda_k2": nrm(ks[16], (L, HEAD_DIM), 0.1),
        "subln_g": gain(ks[17], (L, V_HEAD_DIM)),
        "w_attn_out": nrm(ks[18], (L, ATTN_V_WIDTH, D), ATTN_V_WIDTH ** -0.5),
        "gate_b": nrm(ks[19], (L, N_BRANCHES * D), 0.01),
        "w_out": nrm(ks[20], (L, D, D), D ** -0.5),
        "norm_mlp_g": gain(ks[21], (L, D)),
        "w_mlp_in": nrm(ks[22], (L, D, D_FF), D ** -0.5),
        "w_mlp_out": nrm(ks[23], (L, D_FF, D), D_FF ** -0.5),
    }


def reference(x, c, pos, ada_w, ada_b, norm_mix_g, w_in, conv_w, conv_b, conv_norm_g, w_conv_out,
              q_norm_g, k_norm_g, lambda_q1, lambda_k1, lambda_q2, lambda_k2, subln_g, w_attn_out,
              gate_b, w_out, norm_mlp_g, w_mlp_in, w_mlp_out):
    B, S, D = x.shape
    inv_freq = ROPE_THETA ** (-jnp.arange(0, HEAD_DIM, 2, dtype=jnp.float32) / HEAD_DIM)
    ang = pos.astype(jnp.float32)[:, :, None] * inv_freq[None, None, :]
    cos = jnp.cos(ang)[:, :, None, None, :]
    sin = jnp.sin(ang)[:, :, None, None, :]
    c_act = jax.nn.silu(c)
    split_idx = [CONV_WIDTH, 2 * CONV_WIDTH, 2 * CONV_WIDTH + ATTN_QK_WIDTH,
                 2 * CONV_WIDTH + 2 * ATTN_QK_WIDTH, 2 * CONV_WIDTH + 2 * ATTN_QK_WIDTH + ATTN_V_WIDTH]

    for l in range(DEPTH):
        lam_init = lambda_init_fn(l)
        ada = (c_act @ ada_w[l] + ada_b[l])[:, None, :]
        shift_m, scale_m, gate_m, shift_f, scale_f, gate_f = jnp.split(ada, 6, axis=-1)

        h = rmsnorm(x, norm_mix_g[l]) * (1.0 + scale_m) + shift_m
        u = h @ w_in[l]
        conv_a, conv_g, q, k, v, gate_logits = jnp.split(u, split_idx, axis=-1)
        y_conv = conformer_conv_branch(conv_a, conv_g, conv_w[l], conv_b[l], conv_norm_g[l], w_conv_out[l])
        y_attn = diff_attention_branch(q, k, v, cos, sin, q_norm_g[l], k_norm_g[l],
                                       lambda_q1[l], lambda_k1[l], lambda_q2[l], lambda_k2[l],
                                       subln_g[l], w_attn_out[l], lam_init)
        gates = jax.nn.sigmoid(gate_logits + gate_b[l]).reshape(B, S, N_BRANCHES, D)
        merged = gates[:, :, 0] * y_conv + gates[:, :, 1] * y_attn
        x = x + gate_m * (merged @ w_out[l])

        h = rmsnorm(x, norm_mlp_g[l]) * (1.0 + scale_f) + shift_f
        x = x + gate_f * (jnp.square(jax.nn.relu(h @ w_mlp_in[l])) @ w_mlp_out[l])
    return x
```

```cpp
#include <hip/hip_runtime.h>
#include <hip/hip_cooperative_groups.h>
#include <cstdio>
#include <cstdint>
#include <cmath>
namespace pg8 {
#define PG8_LAS __attribute__((address_space(3)))
typedef unsigned short bf16_t;
typedef short bf16x8 __attribute__((ext_vector_type(8)));
typedef float f32x4 __attribute__((ext_vector_type(4)));
typedef unsigned u32x4 __attribute__((ext_vector_type(4)));
constexpr int BM = 256, BK = 64, HALF = 128, HTB = HALF * BK * 2  , STAGE_BYTES = 8 * HTB, NXCD = 8, WGM = 4;

__host__ __device__ __forceinline__ int lds_byte(int r, int c) { const int st = (r >> 4) * 2 + (c >> 5), rr = r & 15, cc = c & 31, ob = rr * 64 + cc * 2; return st * 1024 + (ob ^ (((ob >> 9) & 1) << 5)); }
__host__ __device__ __forceinline__ void stage_rc(int b, int& R, int& C) { const int st = b / 1024, sb = b % 1024, swz = sb ^ (((sb >> 9) & 1) << 5); R = (st >> 1) * 16 + swz / 64; C = (st & 1) * 32 + (swz % 64) / 2; }
__host__ __device__ __forceinline__ int perm32(int rho) { const int n = rho >> 4, i = rho & 15; return 8 * (i >> 2) + 4 * n + (i & 3); }

struct Unit { int pm, pn; };
struct Gemm { const bf16_t* A; const bf16_t* Bt; int M, N, K; };

struct StaticOrder {
    int nM, nN, nwg, G, c, wgm, rev;
    __host__ __device__ void init(int M, int N, int G_, int c_, int wgm_ = WGM, int rev_ = 0) { nM = M / BM; nN = N / BM; nwg = nM * nN; G = G_; c = c_; wgm = wgm_; rev = rev_; }
    __host__ __device__ bool next(int i, Unit& u) const {
        const long L = (long)i * G + c; if (L >= nwg) return false;
        int wgid = (int)L; { const int q = nwg / NXCD, r = nwg % NXCD, xcd = wgid % NXCD, off = wgid / NXCD; wgid = (xcd < r ? xcd * (q + 1) : r * (q + 1) + (xcd - r) * q) + off; }
        const int nig = wgm * nN, gid = wgid / nig, fm = gid * wgm, gsz = (nM - fm) < wgm ? (nM - fm) : wgm;
        u.pm = fm + ((wgid % nig) % gsz); u.pn = (wgid % nig) / gsz; if (rev) u.pm = nM - 1 - u.pm; return true;
    }
    __device__ __forceinline__ void a_ready(const Unit&) const {}
    __device__ __forceinline__ void done(const Unit&) const {}
};


typedef float f32x2_t __attribute__((ext_vector_type(2))); typedef __bf16 bf16x2_t __attribute__((ext_vector_type(2)));
__device__ __forceinline__ unsigned cvt_pk_bf16(float lo, float hi) { f32x2_t v = {lo, hi}; bf16x2_t b = __builtin_convertvector(v, bf16x2_t); return __builtin_bit_cast(unsigned, b); }
__device__ __forceinline__ float bflo(unsigned w) { return __uint_as_float(w << 16); }
__device__ __forceinline__ float bfhi(unsigned w) { return __uint_as_float(w & 0xffff0000u); }
__device__ __forceinline__ float sigmoidf_(float x) { return __builtin_amdgcn_rcpf(1.0f + __expf(-x)); }
__device__ __forceinline__ u32x4 pack8f(f32x4 v0, f32x4 v1) { u32x4 w; w.x = cvt_pk_bf16(v0[0], v0[1]); w.y = cvt_pk_bf16(v0[2], v0[3]); w.z = cvt_pk_bf16(v1[0], v1[1]); w.w = cvt_pk_bf16(v1[2], v1[3]); return w; }

struct EpiIn {
    static constexpr bool PERM = true, AFTER_DRAIN = false;
    bf16_t* CG; bf16_t* QK; bf16_t* VH; bf16_t* GT; const float* gate_b;
    __device__ __forceinline__ void operator()(const f32x4 (&acc)[2][2][4][2], const Unit& u, int wr, int wc, int fr, int fq) const {
        const int row0 = u.pm * BM + wr * 64 + fr, cin = wc * 32 + 8 * fq, pn = u.pn;
        if (pn < 16) {
            bf16_t* base = (pn < 8 ? CG + pn * BM : QK + (pn - 8) * BM) + cin;
#pragma unroll
            for (int ai = 0; ai < 2; ++ai)
#pragma unroll
                for (int m = 0; m < 4; ++m) { bf16_t* rowp = base + (size_t)(row0 + ai * HALF + m * 16) * 2048;
#pragma unroll
                    for (int bj = 0; bj < 2; ++bj) *(u32x4*)(rowp + bj * HALF) = pack8f(acc[ai][bj][m][0], acc[ai][bj][m][1]); }
        } else if (pn < 20) {
            const int h = pn - 16;
#pragma unroll
            for (int ai = 0; ai < 2; ++ai)
#pragma unroll
                for (int m = 0; m < 4; ++m) { const int r = row0 + ai * HALF + m * 16, b = r >> 13, s = r & 8191;
#pragma unroll
                    for (int bj = 0; bj < 2; ++bj) *(u32x4*)(VH + ((size_t)((b * 8 + h * 2 + bj) * 8192 + s)) * 128 + cin) = pack8f(acc[ai][bj][m][0], acc[ai][bj][m][1]); }
        } else {
            const int c0 = (pn - 20) * BM + cin;
            f32x4 bv[2][2];
#pragma unroll
            for (int bj = 0; bj < 2; ++bj)
#pragma unroll
                for (int n = 0; n < 2; ++n) bv[bj][n] = *(const f32x4*)(gate_b + c0 + bj * HALF + 4 * n);
#pragma unroll
            for (int ai = 0; ai < 2; ++ai)
#pragma unroll
                for (int m = 0; m < 4; ++m) { bf16_t* rowp = GT + (size_t)(row0 + ai * HALF + m * 16) * 4096 + c0;
#pragma unroll
                    for (int bj = 0; bj < 2; ++bj) { f32x4 v0 = acc[ai][bj][m][0] + bv[bj][0], v1 = acc[ai][bj][m][1] + bv[bj][1];
#pragma unroll
                        for (int e = 0; e < 4; ++e) { v0[e] = sigmoidf_(v0[e]); v1[e] = sigmoidf_(v1[e]); }
                        *(u32x4*)(rowp + bj * HALF) = pack8f(v0, v1); } }
        }
    }
};
template <bool ADD> struct EpiMerge {
    static constexpr bool PERM = true, AFTER_DRAIN = false;
    bf16_t* MG; const bf16_t* G;
    __device__ __forceinline__ void operator()(const f32x4 (&acc)[2][2][4][2], const Unit& u, int wr, int wc, int fr, int fq) const {
        const int row0 = u.pm * BM + wr * 64 + fr, c0 = u.pn * BM + wc * 32 + 8 * fq;
#pragma unroll
        for (int ai = 0; ai < 2; ++ai) {
            u32x4 gg[4][2], oo[4][2];
#pragma unroll
            for (int m = 0; m < 4; ++m) { const size_t r = (size_t)(row0 + ai * HALF + m * 16);
#pragma unroll
                for (int bj = 0; bj < 2; ++bj) { gg[m][bj] = *(const u32x4*)(G + r * 4096 + c0 + bj * HALF); if (ADD) oo[m][bj] = *(const u32x4*)(MG + r * 2048 + c0 + bj * HALF); } }
#pragma unroll
            for (int m = 0; m < 4; ++m) { const size_t r = (size_t)(row0 + ai * HALF + m * 16);
#pragma unroll
                for (int bj = 0; bj < 2; ++bj) { const u32x4 g = gg[m][bj]; bf16_t* op = MG + r * 2048 + c0 + bj * HALF;
                    f32x4 v0 = acc[ai][bj][m][0], v1 = acc[ai][bj][m][1];
                    v0[0] *= bflo(g.x); v0[1] *= bfhi(g.x); v0[2] *= bflo(g.y); v0[3] *= bfhi(g.y); v1[0] *= bflo(g.z); v1[1] *= bfhi(g.z); v1[2] *= bflo(g.w); v1[3] *= bfhi(g.w);
                    if (ADD) { const u32x4 o = oo[m][bj]; v0[0] += bflo(o.x); v0[1] += bfhi(o.x); v0[2] += bflo(o.y); v0[3] += bfhi(o.y); v1[0] += bflo(o.z); v1[1] += bfhi(o.z); v1[2] += bflo(o.w); v1[3] += bfhi(o.w); }
                    *(u32x4*)op = pack8f(v0, v1); } }
        }
    }
};
struct EpiRes {
    static constexpr bool PERM = false, AFTER_DRAIN = false;
    const float* base; float* out; const float* gate;
    __device__ __forceinline__ void operator()(const f32x4 (&acc)[2][2][4][2], const Unit& u, int wr, int wc, int fr, int fq) const {
        const int row0 = u.pm * BM + wr * 64 + fr, c0 = u.pn * BM + wc * 32 + 4 * fq; const float* gp = gate + (size_t)(u.pm >> 5) * 12288 + c0;
        f32x4 gv[2][2];
#pragma unroll
        for (int bj = 0; bj < 2; ++bj)
#pragma unroll
            for (int n = 0; n < 2; ++n) gv[bj][n] = *(const f32x4*)(gp + bj * HALF + n * 16);
#pragma unroll
        for (int ai = 0; ai < 2; ++ai) {
            f32x4 bs[4][2][2];
#pragma unroll
            for (int m = 0; m < 4; ++m) { const size_t off = (size_t)(row0 + ai * HALF + m * 16) * 2048 + c0;
#pragma unroll
                for (int bj = 0; bj < 2; ++bj)
#pragma unroll
                    for (int n = 0; n < 2; ++n) bs[m][bj][n] = *(const f32x4*)(base + off + bj * HALF + n * 16); }
#pragma unroll
            for (int m = 0; m < 4; ++m) { const size_t off = (size_t)(row0 + ai * HALF + m * 16) * 2048 + c0;
#pragma unroll
                for (int bj = 0; bj < 2; ++bj)
#pragma unroll
                    for (int n = 0; n < 2; ++n) *(f32x4*)(out + off + bj * HALF + n * 16) = bs[m][bj][n] + gv[bj][n] * acc[ai][bj][m][n]; }
        }
    }
};
struct EpiRelu2 {
    static constexpr bool PERM = true, AFTER_DRAIN = false;
    bf16_t* O; int ldc;
    __device__ __forceinline__ void operator()(const f32x4 (&acc)[2][2][4][2], const Unit& u, int wr, int wc, int fr, int fq) const {
        const int row0 = u.pm * BM + wr * 64 + fr, c0 = u.pn * BM + wc * 32 + 8 * fq;
#pragma unroll
        for (int ai = 0; ai < 2; ++ai)
#pragma unroll
            for (int m = 0; m < 4; ++m) { bf16_t* rowp = O + (size_t)(row0 + ai * HALF + m * 16) * ldc + c0;
#pragma unroll
                for (int bj = 0; bj < 2; ++bj) { f32x4 v0 = acc[ai][bj][m][0], v1 = acc[ai][bj][m][1];
#pragma unroll
                    for (int e = 0; e < 4; ++e) { const float a = fmaxf(v0[e], 0.f), b = fmaxf(v1[e], 0.f); v0[e] = a * a; v1[e] = b * b; }
                    *(u32x4*)(rowp + bj * HALF) = pack8f(v0, v1); } }
    }
};

template <class Epi, class Sched, bool ALIGN_EPI = false, bool SP2 = false>
__device__ __forceinline__ void gemm_phase(PG8_LAS unsigned char* lds, const Gemm g, const Sched& S, const Epi& E) {
    int tid_ = threadIdx.x; asm volatile("" : "+v"(tid_));
    const int tid = tid_, wid = __builtin_amdgcn_readfirstlane(tid >> 6), lane = tid & 63, wr = wid >> 2, wc = wid & 3, fr = lane & 15, fq = lane >> 4;
    const int K = g.K, nt = K / BK;
    unsigned voffA[2], voffB[2];
#pragma unroll
    for (int i = 0; i < 2; ++i) { int R, C; stage_rc(tid * 16 + i * 8192, R, C); const int Rb = Epi::PERM ? ((R & ~31) + perm32(R & 31)) : R;
        voffA[i] = (unsigned)(R * K + C) * 2u; voffB[i] = (unsigned)(Rb * K + C) * 2u; }
    const size_t kstep = (size_t)(BK * 2);
    const size_t hstep = (size_t)HALF * K * 2;
    const size_t tstep = 2 * hstep;
    const unsigned ldsw = (unsigned)wid * 1024u;
    const int aoff = lds_byte(wr * 64 + fr, fq * 8), boff = lds_byte(wc * 32 + fr, fq * 8);
#define PG8_SA(b, h) (((b) * 2 + (h)) * HTB)
#define PG8_SB(b, h) ((4 + (b) * 2 + (h)) * HTB)
#define PG8_STAGE(bufoff, gbase, voff) do { _Pragma("unroll") for (int _i = 0; _i < 2; ++_i) \
        __builtin_amdgcn_global_load_lds((const unsigned*)((const char*)(gbase) + (voff)[_i]), (PG8_LAS unsigned*)(lds + (bufoff) + ldsw + _i * 8192), 16, 0, 0); } while (0)
#define PG8_LDA(dst, b, h) do { _Pragma("unroll") for (int m = 0; m < 4; ++m) _Pragma("unroll") for (int k = 0; k < 2; ++k) dst[m][k] = *(const PG8_LAS bf16x8*)(lds + PG8_SA(b, h) + aoff + m * 2048 + k * 1024); } while (0)
#define PG8_LDB(dst, b, h) do { _Pragma("unroll") for (int n = 0; n < 2; ++n) _Pragma("unroll") for (int k = 0; k < 2; ++k) dst[n][k] = *(const PG8_LAS bf16x8*)(lds + PG8_SB(b, h) + boff + n * 2048 + k * 1024); } while (0)
#define PG8_MMA(ai, bj, At, Bt) do { __builtin_amdgcn_s_setprio(1); _Pragma("unroll") for (int m = 0; m < 4; ++m) _Pragma("unroll") for (int n = 0; n < 2; ++n) _Pragma("unroll") for (int k = 0; k < 2; ++k) \
        acc[ai][bj][m][n] = __builtin_amdgcn_mfma_f32_16x16x32_bf16(Bt[n][k], At[m][k], acc[ai][bj][m][n], 0, 0, 0); __builtin_amdgcn_s_setprio(0); } while (0)
#define PG8_WAIT_V(n) asm volatile("s_waitcnt vmcnt(" #n ")" ::: "memory")
#define PG8_WAIT_L(n) asm volatile("s_waitcnt lgkmcnt(" #n ")" ::: "memory")
#define PG8_BAR __builtin_amdgcn_s_barrier()
#define PG8_SCHED __builtin_amdgcn_sched_barrier(0)
    Unit cur, nxt; int ui = 0;
    if (!S.next(0, cur)) return;
    f32x4 acc[2][2][4][2];
#pragma unroll
    for (int a = 0; a < 2; ++a)
#pragma unroll
        for (int b = 0; b < 2; ++b)
#pragma unroll
            for (int m = 0; m < 4; ++m)
#pragma unroll
                for (int n = 0; n < 2; ++n) acc[a][b][m][n] = (f32x4){0.f, 0.f, 0.f, 0.f};
    bf16x8 At[4][2], B0[2][2], B1[2][2];
    const char* cA = (const char*)g.A + (size_t)cur.pm * tstep; const char* cB = (const char*)g.Bt + (size_t)cur.pn * tstep;
    S.a_ready(cur);
    if constexpr (SP2) {
        PG8_STAGE(PG8_SB(0, 0), cB, voffB); PG8_STAGE(PG8_SB(0, 1), cB + hstep, voffB); PG8_STAGE(PG8_SA(0, 0), cA, voffA); PG8_STAGE(PG8_SA(0, 1), cA + hstep, voffA);
        if (wr == 1) PG8_BAR;
        PG8_WAIT_V(2); PG8_BAR;
        PG8_STAGE(PG8_SB(1, 0), cB + kstep, voffB); PG8_STAGE(PG8_SA(1, 0), cA + kstep, voffA); PG8_STAGE(PG8_SB(1, 1), cB + hstep + kstep, voffB);
        PG8_WAIT_V(6); PG8_BAR;
    } else {
        PG8_STAGE(PG8_SB(0, 0), cB, voffB); PG8_STAGE(PG8_SA(0, 0), cA, voffA); PG8_STAGE(PG8_SB(0, 1), cB + hstep, voffB); PG8_STAGE(PG8_SA(0, 1), cA + hstep, voffA);
        if (wr == 1) PG8_BAR;
        PG8_WAIT_V(4); PG8_BAR;
        PG8_STAGE(PG8_SB(1, 0), cB + kstep, voffB); PG8_STAGE(PG8_SA(1, 0), cA + kstep, voffA); PG8_STAGE(PG8_SB(1, 1), cB + hstep + kstep, voffB);
        PG8_WAIT_V(6); PG8_BAR;
    }
    for (;;) {
        const bool has_next = S.next(ui + 1, nxt);
        const char* nA = has_next ? (const char*)g.A + (size_t)nxt.pm * tstep : cA; const char* nB = has_next ? (const char*)g.Bt + (size_t)nxt.pn * tstep : cB;
        for (int t = 0; t < nt; t += 2) {
            const bool last = (t == nt - 2);
            const char* a1 = cA + (size_t)(t + 1) * kstep;
            const char* a2 = last ? nA : cA + (size_t)(t + 2) * kstep; const char* b2 = last ? nB : cB + (size_t)(t + 2) * kstep;
            const char* a3 = a2 + kstep; const char* b3 = b2 + kstep;
            if (last && has_next) S.a_ready(nxt);
            if constexpr (SP2) {
            PG8_LDB(B0, 0, 0); PG8_LDB(B1, 0, 1); PG8_SCHED; PG8_LDA(At, 0, 0); PG8_STAGE(PG8_SA(1, 1), a1 + hstep, voffA);
            PG8_WAIT_V(8); PG8_WAIT_L(0); PG8_BAR; PG8_MMA(0, 0, At, B0); PG8_MMA(0, 1, At, B1); PG8_BAR; PG8_SCHED;
            PG8_LDA(At, 0, 1); PG8_STAGE(PG8_SB(0, 0), b2, voffB); PG8_STAGE(PG8_SB(0, 1), b2 + hstep, voffB); PG8_STAGE(PG8_SA(0, 0), a2, voffA);
            PG8_WAIT_V(8); PG8_WAIT_L(0); PG8_BAR; PG8_MMA(1, 0, At, B0); PG8_MMA(1, 1, At, B1); PG8_BAR; PG8_SCHED;
            PG8_LDB(B0, 1, 0); PG8_LDB(B1, 1, 1); PG8_SCHED; PG8_LDA(At, 1, 0); PG8_STAGE(PG8_SA(0, 1), a2 + hstep, voffA);
            PG8_WAIT_V(8); PG8_WAIT_L(0); PG8_BAR; PG8_MMA(0, 0, At, B0); PG8_MMA(0, 1, At, B1); PG8_BAR; PG8_SCHED;
            PG8_LDA(At, 1, 1); PG8_STAGE(PG8_SB(1, 0), b3, voffB); PG8_STAGE(PG8_SB(1, 1), b3 + hstep, voffB); PG8_STAGE(PG8_SA(1, 0), a3, voffA);
            PG8_WAIT_V(8); PG8_WAIT_L(0); PG8_BAR; PG8_MMA(1, 0, At, B0); PG8_MMA(1, 1, At, B1); PG8_BAR; PG8_SCHED;
            } else {
            PG8_LDB(B0, 0, 0); PG8_SCHED; PG8_LDA(At, 0, 0); PG8_STAGE(PG8_SA(1, 1), a1 + hstep, voffA);
            PG8_WAIT_L(8); PG8_BAR; PG8_WAIT_L(0); PG8_MMA(0, 0, At, B0); PG8_BAR; PG8_SCHED;
            PG8_LDB(B1, 0, 1); PG8_STAGE(PG8_SB(0, 0), b2, voffB);
            PG8_BAR; PG8_WAIT_L(0); PG8_MMA(0, 1, At, B1); PG8_BAR;
            PG8_LDA(At, 0, 1); PG8_STAGE(PG8_SA(0, 0), a2, voffA);
            PG8_BAR; PG8_WAIT_L(0); PG8_MMA(1, 0, At, B0); PG8_BAR; PG8_SCHED;
            PG8_STAGE(PG8_SB(0, 1), b2 + hstep, voffB);
            PG8_WAIT_V(6); PG8_BAR; PG8_MMA(1, 1, At, B1); PG8_BAR;
            PG8_LDB(B0, 1, 0); PG8_SCHED; PG8_LDA(At, 1, 0); PG8_STAGE(PG8_SA(0, 1), a2 + hstep, voffA);
            PG8_WAIT_L(8); PG8_BAR; PG8_WAIT_L(0); PG8_MMA(0, 0, At, B0); PG8_BAR; PG8_SCHED;
            PG8_LDB(B1, 1, 1); PG8_STAGE(PG8_SB(1, 0), b3, voffB);
            PG8_BAR; PG8_WAIT_L(0); PG8_MMA(0, 1, At, B1); PG8_BAR;
            PG8_LDA(At, 1, 1); PG8_STAGE(PG8_SA(1, 0), a3, voffA);
            PG8_BAR; PG8_WAIT_L(0); PG8_MMA(1, 0, At, B0); PG8_BAR; PG8_SCHED;
            PG8_STAGE(PG8_SB(1, 1), b3 + hstep, voffB);
            PG8_WAIT_V(6); PG8_BAR; PG8_MMA(1, 1, At, B1); PG8_BAR;
            }
        }
        if constexpr (ALIGN_EPI) { if (wr == 0) PG8_BAR; }
        if constexpr (!Epi::AFTER_DRAIN) { E(acc, cur, wr, wc, fr, fq); S.done(cur); }
        if (!has_next) break;
#pragma unroll
        for (int a = 0; a < 2; ++a)
#pragma unroll
            for (int b = 0; b < 2; ++b)
#pragma unroll
                for (int m = 0; m < 4; ++m)
#pragma unroll
                    for (int n = 0; n < 2; ++n) acc[a][b][m][n] = (f32x4){0.f, 0.f, 0.f, 0.f};
        cur = nxt; cA = nA; cB = nB; ++ui;
        if constexpr (ALIGN_EPI) { if (wr == 1) PG8_BAR; }
    }
    PG8_WAIT_V(0);
    if constexpr (!ALIGN_EPI) { if (wr == 0) PG8_BAR; }
    PG8_BAR;
    if constexpr (Epi::AFTER_DRAIN) { E.fused(acc, cur, wr, wc, fr, fq, lds, wid, lane); S.done(cur); }
#undef PG8_SA
#undef PG8_SB
#undef PG8_STAGE
#undef PG8_LDA
#undef PG8_LDB
#undef PG8_MMA
#undef PG8_WAIT_V
#undef PG8_WAIT_L
#undef PG8_BAR
#undef PG8_SCHED
}
}

namespace att {
constexpr int D = 128;
constexpr float SCALE = 0.08838834764831845f;
constexpr float THR = 8.f;
constexpr int NW = 8, QBLK = 32, KVBLK = 64, QB = NW * QBLK;
constexpr int SHM_V = KVBLK * D * 2, SHM_K = KVBLK * D * 2;
constexpr int LDS_BYTES = 2 * SHM_V + 2 * SHM_K + NW * 64 * 4;
typedef unsigned short bf16;
typedef short bf16x8 __attribute__((ext_vector_type(8)));
typedef short s16x4 __attribute__((ext_vector_type(4)));
typedef float f32x16 __attribute__((ext_vector_type(16)));
typedef float f32x4 __attribute__((ext_vector_type(4)));
typedef unsigned u32x4 __attribute__((ext_vector_type(4)));
#define KSWZ(row, colB) ((row) * 256 + ((colB) ^ (((row) & 7) << 4)))
#define SBAR() __builtin_amdgcn_sched_barrier(0)
__device__ __forceinline__ int v_st(int k, int c) { const int kk = (k & ~0xC) | ((k & 4) << 1) | ((k & 8) >> 1); return ((kk >> 3) * 4 + (c >> 5)) * 512 + ((kk & 7) * 32 + (c & 31)) * 2; }
__device__ __forceinline__ int v_rd_base(int lane) { return ((lane & 3) << 3) | (((lane >> 2) & 3) << 6) | (((lane >> 4) & 1) << 5) | (((lane >> 5) & 1) << 8); }
constexpr int v_rd_off(int d0, int ks, int half) { return d0 * 512 + ks * 4096 + half * 2048; }
__device__ __forceinline__ int crow(int r, int hi) { return (r & 3) + 8 * (r >> 2) + 4 * hi; }
__device__ __forceinline__ unsigned cvtpk(float lo, float hi) { return pg8::cvt_pk_bf16(lo, hi); }
__device__ __forceinline__ bf16x8 load8(const bf16* p) { return *reinterpret_cast<const bf16x8*>(p); }
__device__ __forceinline__ void partialSM(f32x16& p0, f32x16& p1, float& m_reg, float& mn, float& alpha) {
    float pmax = p0[0]; for (int r = 1; r < 16; ++r) pmax = fmaxf(pmax, p0[r]); for (int r = 0; r < 16; ++r) pmax = fmaxf(pmax, p1[r]);
    { auto rr = __builtin_amdgcn_permlane32_swap(__float_as_uint(pmax), __float_as_uint(pmax), false, false);
      pmax = fmaxf(__uint_as_float(rr[0]), __uint_as_float(rr[1])); }
    constexpr float C2 = 1.4426950408889634f * SCALE;
    if (__builtin_expect(__all((pmax - m_reg) * SCALE <= THR), 1)) { mn = m_reg; alpha = 1.f; }
    else { mn = fmaxf(m_reg, pmax); alpha = __builtin_amdgcn_exp2f((m_reg - mn) * C2); m_reg = mn; }
    const float mnL = -mn * C2;
    for (int r = 0; r < 16; ++r) p0[r] = fmaf(p0[r], C2, mnL); for (int r = 0; r < 16; ++r) p1[r] = fmaf(p1[r], C2, mnL);
    for (int r = 0; r < 16; ++r) p0[r] = __builtin_amdgcn_exp2f(p0[r]);
}
__device__ __forceinline__ void finishSM(f32x16& p0, f32x16& p1, float alpha, float& l_reg, bf16x8& pa0, bf16x8& pa1, bf16x8& pa2, bf16x8& pa3) {
    for (int r = 0; r < 16; ++r) p1[r] = __builtin_amdgcn_exp2f(p1[r]);
    float ps = 0; for (int r = 0; r < 16; ++r) ps += p0[r]; for (int r = 0; r < 16; ++r) ps += p1[r];
    { auto rr = __builtin_amdgcn_permlane32_swap(__float_as_uint(ps), __float_as_uint(ps), false, false);
      ps = __uint_as_float(rr[0]) + __uint_as_float(rr[1]); }
    l_reg = l_reg * alpha + ps;
#define PK4(P, B_, OUT) do { unsigned a0 = cvtpk(P[B_+0], P[B_+1]), a1 = cvtpk(P[B_+2], P[B_+3]);                          \
        unsigned b0 = cvtpk(P[B_+4], P[B_+5]), b1 = cvtpk(P[B_+6], P[B_+7]);                                             \
        auto r0 = __builtin_amdgcn_permlane32_swap(a0, b0, false, false); auto r1 = __builtin_amdgcn_permlane32_swap(a1, b1, false, false); \
        u32x4 w = {r0[0], r1[0], r0[1], r1[1]}; OUT = *reinterpret_cast<bf16x8*>(&w); } while (0)
    PK4(p0, 0, pa0); PK4(p0, 8, pa1); PK4(p1, 0, pa2); PK4(p1, 8, pa3);
#undef PK4
}
template <int KB>
__device__ __forceinline__ void qkt(f32x16& p0, f32x16& p1, const char* K_lds, int r32, int hi, const bf16x8* qr) {
    p0 = f32x16{}; p1 = f32x16{};
    const char* kb[4];
#pragma unroll
    for (int dd = 0; dd < 4; ++dd) kb[dd] = K_lds + KB * SHM_K + KSWZ(r32, (dd * 16 + hi * 8) * 2);
#pragma unroll
    for (int d0 = 0; d0 < 8; ++d0) { const char* a = kb[d0 & 3] + (d0 >> 2) * 128;
        bf16x8 b0 = *reinterpret_cast<const bf16x8*>(a);
        bf16x8 b1 = *reinterpret_cast<const bf16x8*>(a + 32 * 256);
        p0 = __builtin_amdgcn_mfma_f32_32x32x16_bf16(b0, qr[d0], p0, 0, 0, 0);
        p1 = __builtin_amdgcn_mfma_f32_32x32x16_bf16(b1, qr[d0], p1, 0, 0, 0); }
}
template <int VB>
__device__ __forceinline__ void pv_tile(f32x16* o, int vb0, bf16x8 pa0, bf16x8 pa1, bf16x8 pa2, bf16x8 pa3) {
#define TRRD(dst, off) asm volatile("ds_read_b64_tr_b16 %0, %1 offset:%2" : "=&v"(dst) : "v"(vb0), "i"(off) : "memory")
#define PV_D0(d0) do { s16x4 l0, l1, l2, l3, h0, h1, h2, h3; constexpr int b_ = VB * SHM_V + v_rd_off(d0, 0, 0); \
        TRRD(l0, b_); TRRD(h0, b_ + 2048); TRRD(l1, b_ + 4096); TRRD(h1, b_ + 6144); TRRD(l2, b_ + 8192); TRRD(h2, b_ + 10240); TRRD(l3, b_ + 12288); TRRD(h3, b_ + 14336); \
        asm volatile("s_waitcnt lgkmcnt(0)" ::: "memory"); SBAR(); \
        o[d0] = __builtin_amdgcn_mfma_f32_32x32x16_bf16(pa0, (bf16x8){l0[0], l0[1], l0[2], l0[3], h0[0], h0[1], h0[2], h0[3]}, o[d0], 0, 0, 0);   \
        o[d0] = __builtin_amdgcn_mfma_f32_32x32x16_bf16(pa1, (bf16x8){l1[0], l1[1], l1[2], l1[3], h1[0], h1[1], h1[2], h1[3]}, o[d0], 0, 0, 0);   \
        o[d0] = __builtin_amdgcn_mfma_f32_32x32x16_bf16(pa2, (bf16x8){l2[0], l2[1], l2[2], l2[3], h2[0], h2[1], h2[2], h2[3]}, o[d0], 0, 0, 0);   \
        o[d0] = __builtin_amdgcn_mfma_f32_32x32x16_bf16(pa3, (bf16x8){l3[0], l3[1], l3[2], l3[3], h3[0], h3[1], h3[2], h3[3]}, o[d0], 0, 0, 0); } while (0)
    PV_D0(0); PV_D0(1); PV_D0(2); PV_D0(3);
#undef PV_D0
#undef TRRD
}
struct BlockRef { const bf16* Q; const bf16* K; const bf16* V; bf16* O; int P0; };
struct Seam { bf16x8 qr[8]; bf16x8 st_v0, st_v1, st_k0, st_k1; };
#define ROW(p, k0, rr) ((p) + (size_t)((k0) + (rr)) * D + sc)
#define VMW() asm volatile("s_waitcnt vmcnt(0)" ::: "memory")
#define VMWN(n) asm volatile("s_waitcnt vmcnt(%0)" :: "i"(n) : "memory")
#define SLOAD_H(Kp, Vp, k0) do { S.st_v0 = load8(ROW(Vp, k0, sr)); S.st_v1 = load8(ROW(Vp, k0, 32 + sr)); S.st_k0 = load8(ROW(Kp, k0, sr)); S.st_k1 = load8(ROW(Kp, k0, 32 + sr)); } while (0)
#define SWRITE_HK(bf) do { *(bf16x8*)(K_lds + (bf) * SHM_K + kws) = S.st_k0; *(bf16x8*)(K_lds + (bf) * SHM_K + kws + 32 * 256) = S.st_k1; } while (0)
#define SWRITE_HV(bf) do { *(bf16x8*)(V_lds + (bf) * SHM_V + vst0) = S.st_v0; *(bf16x8*)(V_lds + (bf) * SHM_V + vst1) = S.st_v1; } while (0)
#define SWRITE_H(bf) do { SWRITE_HV(bf); SWRITE_HK(bf); } while (0)
__device__ __forceinline__ void attn_prime(const BlockRef& cur, char* lds, Seam& S) {
    int tid_ = threadIdx.x; asm volatile("" : "+v"(tid_));
    const int tid = tid_, wid = __builtin_amdgcn_readfirstlane(tid >> 6), lane = tid & 63, r32 = lane & 31, hi = lane >> 5;
    const int sr = tid >> 4, sc = (tid & 15) * 8, kws = KSWZ(sr, sc * 2); char* K_lds = lds + 2 * SHM_V;
    for (int d0 = 0; d0 < 8; ++d0) S.qr[d0] = load8(cur.Q + (size_t)(wid * QBLK + r32) * D + d0 * 16 + hi * 8);
    SLOAD_H(cur.K, cur.V, 0); VMW(); SWRITE_HK(0);
    __syncthreads();
}
__device__ __forceinline__ void attn_block(const BlockRef& cur, const BlockRef& nxt, char* lds, Seam& S) {
    int tid_ = threadIdx.x; asm volatile("" : "+v"(tid_));
    const int tid = tid_, wid = __builtin_amdgcn_readfirstlane(tid >> 6), lane = tid & 63, r32 = lane & 31, hi = lane >> 5;
    const int NT = (cur.P0 + QB) / KVBLK;
    const int qlo = cur.P0 + wid * QBLK;
    char* V_lds = lds; char* K_lds = lds + 2 * SHM_V;
    float* ws = (float*)(lds + 2 * SHM_V + 2 * SHM_K) + wid * 64; float* li_l = ws, * al_l = ws + 32;
    float m_reg = -1e30f, l_reg = 0; f32x16 o[4] = {};
    const int sr = tid >> 4, sc = (tid & 15) * 8, vst0 = v_st(sr, sc), vst1 = v_st(32 + sr, sc), kws = KSWZ(sr, sc * 2);
    const int vb0 = (int)(uintptr_t)V_lds + v_rd_base(lane);
    const bf16* Kh = cur.K; const bf16* Vh = cur.V;
#define RESC(a) do { if (__any((a) < 1.f)) { if (hi == 0) al_l[r32] = (a); asm volatile("s_waitcnt lgkmcnt(0)" ::: "memory");              \
                     for (int d_ = 0; d_ < 4; ++d_) for (int r = 0; r < 16; ++r) o[d_][r] *= al_l[crow(r, hi)]; } } while (0)
#define KBASE(t) ((t) * KVBLK)
#define MASKT(P0_, P1_, t) do { if (KBASE(t) > (qlo | 63)) { const float NEG_ = -__builtin_inff(); _Pragma("unroll") for (int r_ = 0; r_ < 16; ++r_) { P0_[r_] = NEG_; P1_[r_] = NEG_; } } } while (0)
    constexpr int NQL = 8;
#define SEAM_K0() do { VMWN(NQL); SWRITE_HK(0); SBAR(); } while (0)
    f32x16 pA0, pA1, pB0, pB1; float mnA, mnB, alA, alB; bf16x8 pa0, pa1, pa2, pa3;
    SWRITE_HV(0); SBAR();
    if (NT > 1) { SLOAD_H(Kh, Vh, KBASE(1)); }
    SBAR(); qkt<0>(pA0, pA1, K_lds, r32, hi, S.qr);
    MASKT(pA0, pA1, 0); partialSM(pA0, pA1, m_reg, mnA, alA);
    if (NT > 1) { VMW(); SWRITE_H(1); }
    __syncthreads();
#define HALF_STEP(PX0, PX1, mnX, alX, PY0, PY1, alY, t, KB, VB, SB) do {                                                      \
        SBAR(); qkt<KB>(PX0, PX1, K_lds, r32, hi, S.qr);                                                                      \
        finishSM(PY0, PY1, alY, l_reg, pa0, pa1, pa2, pa3); SBAR();                                                           \
        if ((t) + 1 < NT) { SLOAD_H(Kh, Vh, KBASE((t) + 1)); SBAR(); }                                                        \
        pv_tile<VB>(o, vb0, pa0, pa1, pa2, pa3); MASKT(PX0, PX1, (t)); partialSM(PX0, PX1, m_reg, mnX, alX);                  \
        __syncthreads();                                                                                                      \
        if ((t) + 1 < NT) { VMW(); SWRITE_H(SB); }                                                                            \
        RESC(alX); __syncthreads(); } while (0)
    for (int t = 1; t + 1 < NT; t += 2) {
        HALF_STEP(pB0, pB1, mnB, alB, pA0, pA1, alA, t, 1, 0, 0);
        HALF_STEP(pA0, pA1, mnA, alA, pB0, pB1, alB, t + 1, 0, 1, 1);
    }
    const bool even = (NT & 1) == 0;
    const bool actL = KBASE(NT - 1) <= (qlo | 63), actP = KBASE(NT - 2) <= (qlo | 63);
    if (even) { SBAR(); if (actL) qkt<1>(pB0, pB1, K_lds, r32, hi, S.qr); else { const float NEG_ = -__builtin_inff(); _Pragma("unroll") for (int r_ = 0; r_ < 16; ++r_) { pB0[r_] = NEG_; pB1[r_] = NEG_; } } SBAR(); }
    { const int sr_ = sr; (void)sr_; SLOAD_H(nxt.K, nxt.V, 0); SBAR();
#pragma unroll
      for (int d0 = 0; d0 < 8; ++d0) S.qr[d0] = load8(nxt.Q + (size_t)(wid * QBLK + r32) * D + d0 * 16 + hi * 8); }
    SBAR();
    finishSM(pA0, pA1, alA, l_reg, pa0, pa1, pa2, pa3); SBAR();
    if (actP) pv_tile<0>(o, vb0, pa0, pa1, pa2, pa3);
    if (even) { MASKT(pB0, pB1, NT - 1); partialSM(pB0, pB1, m_reg, mnB, alB); __syncthreads(); RESC(alB);
        finishSM(pB0, pB1, alB, l_reg, pa0, pa1, pa2, pa3); SBAR(); if (actL) pv_tile<1>(o, vb0, pa0, pa1, pa2, pa3); }
    SBAR(); SEAM_K0();
    if (hi == 0) li_l[r32] = l_reg; asm volatile("s_waitcnt lgkmcnt(0)" ::: "memory");
    float rli[16];
#pragma unroll
    for (int r = 0; r < 16; ++r) rli[r] = __builtin_amdgcn_rcpf(li_l[crow(r, hi)]);
    bf16* Ow = cur.O + (size_t)(wid * QBLK) * D;
#pragma unroll
    for (int r = 0; r < 16; ++r) { const int orow = crow(r, hi);
#pragma unroll
        for (int d0 = 0; d0 < 4; ++d0) { const float v = o[d0][r] * rli[r];
            const float vn = __shfl_xor(v, 1);
            if ((r32 & 1) == 0) *(unsigned*)(Ow + (size_t)orow * D + d0 * 32 + r32) = cvtpk(v, vn); } }
    __syncthreads();
#undef RESC
#undef KBASE
#undef MASKT
#undef SEAM_K0
#undef HALF_STEP
}
#undef ROW
#undef VMW
#undef VMWN
#undef SLOAD_H
#undef SWRITE_HK
#undef SWRITE_HV
#undef SWRITE_H
#undef SBAR
#undef KSWZ
}

#ifndef WGM_P2
#define WGM_P2 4
#endif
#ifndef WGM_P9
#define WGM_P9 8
#endif
#ifndef WGM_P6
#define WGM_P6 4
#endif
#ifndef WGM_P7
#define WGM_P7 4
#endif
#ifndef WGM_P10
#define WGM_P10 2
#endif
#ifndef REV_P10
#define REV_P10 0
#endif
#ifndef PHM
#define PHM 0xFFFF
#endif
#ifndef DUPM
#define DUPM 0
#endif
namespace cg = cooperative_groups;
#define LAS __attribute__((address_space(3)))
typedef unsigned short bf16;
typedef unsigned v4u __attribute__((ext_vector_type(4)));
typedef unsigned v2u __attribute__((ext_vector_type(2)));
typedef float f32x4 __attribute__((ext_vector_type(4)));
typedef float f32x2 __attribute__((ext_vector_type(2)));

constexpr int NWAVES = 8, NTHR = 512;
constexpr int BATCH = 4, SEQ = 8192, DM = 2048, T = BATCH * SEQ, FF = 8192, INW = 9216, CW = 1024, NADA = 6 * DM;
constexpr float EPS = 1e-6f;
constexpr size_t MiB = 1u << 20;
constexpr size_t WS_ADA = 0, WS_WIN = 2 * MiB, WS_WC = 38 * MiB, WS_WA = 42 * MiB, WS_WO = 46 * MiB, WS_W1 = 54 * MiB, WS_W2 = 86 * MiB;
constexpr size_t WS_XN = 120 * MiB, WS_CG = 248 * MiB, WS_O16 = 248 * MiB, WS_QKR = 376 * MiB, WS_OA = 376 * MiB, WS_GT = 504 * MiB;
constexpr size_t WS_QH = 760 * MiB, WS_KH = 824 * MiB, WS_VH = 888 * MiB, WS_MG = 760 * MiB, WS_YC = 952 * MiB, WS_HB = 248 * MiB, WS_END = 1016 * MiB;
constexpr int LDS_BYTES = 147456;
constexpr int MISC_OFF = 147456 - 256;
constexpr size_t WS_CTL = 1 * MiB, CTL_BYTES = 16384;

struct Args { const void* in[24]; float* out; unsigned char* ws; };

__device__ __forceinline__ float bf2f(unsigned short u) { return __uint_as_float((unsigned)u << 16); }
__device__ __forceinline__ float wave_sum(float v) {
#pragma unroll
    for (int o = 1; o < 64; o <<= 1) v += __shfl_xor(v, o);
    return v;
}
__device__ __forceinline__ float sigm(float x) { return 1.0f / (1.0f + __expf(-x)); }

__device__ __forceinline__ void transpose_item(const float* W, int K, int N, bf16* WT, LAS float* scr, int item, int lane) {
    const int nblk = N / 64, kb = item / nblk, nb = item % nblk, k0 = 64 * kb, n0 = 64 * nb;
    f32x4 v[16];
#pragma unroll
    for (int i = 0; i < 16; ++i) v[i] = *(const f32x4*)(W + (size_t)(k0 + 4 * i + (lane >> 4)) * N + n0 + (lane & 15) * 4);
#pragma unroll
    for (int i = 0; i < 16; ++i) { LAS float* d = scr + (4 * i + (lane >> 4)) * 65 + (lane & 15) * 4; d[0] = v[i].x; d[1] = v[i].y; d[2] = v[i].z; d[3] = v[i].w; }
    asm volatile("s_waitcnt lgkmcnt(0)" ::: "memory");
    const int c = lane & 7;
#pragma unroll
    for (int j = 0; j < 8; ++j) { const int n = (lane >> 3) + 8 * j; const LAS float* s = scr + (8 * c) * 65 + n;
        v4u o; o.x = pg8::cvt_pk_bf16(s[0 * 65], s[1 * 65]); o.y = pg8::cvt_pk_bf16(s[2 * 65], s[3 * 65]); o.z = pg8::cvt_pk_bf16(s[4 * 65], s[5 * 65]); o.w = pg8::cvt_pk_bf16(s[6 * 65], s[7 * 65]);
        *(v4u*)(WT + (size_t)(n0 + n) * K + k0 + 8 * c) = o; }
    asm volatile("s_waitcnt lgkmcnt(0)" ::: "memory");
}

__device__ __forceinline__ void norm_mod_rows(const float* x, const float* g, const float* ada, int shift_off, int scale_off, bf16* XN, int gw, int NGW, int lane) {
    for (int chunk = gw; chunk < T / 16; chunk += NGW) {
        const int b = (chunk * 16) >> 13;
        f32x4 ca[8], cb[8];
#pragma unroll
        for (int j = 0; j < 8; ++j) { const int c = (lane + 64 * j) * 4; const f32x4 gg = *(const f32x4*)(g + c), sc = *(const f32x4*)(ada + b * NADA + scale_off + c);
            ca[j] = gg * (sc + 1.0f); cb[j] = *(const f32x4*)(ada + b * NADA + shift_off + c); }
        f32x4 v[8], vn[8];
        { const f32x4* xr = (const f32x4*)(x + (size_t)chunk * 16 * DM) + lane;
#pragma unroll
          for (int j = 0; j < 8; ++j) v[j] = xr[64 * j]; }
        for (int i = 0; i < 16; ++i) {
            const size_t row = (size_t)chunk * 16 + i;
            { const f32x4* xr = (const f32x4*)(x + (row + (i < 15 ? 1 : 0)) * DM) + lane;
#pragma unroll
              for (int j = 0; j < 8; ++j) vn[j] = xr[64 * j]; }
            float s = 0.f;
#pragma unroll
            for (int j = 0; j < 8; ++j) s += (v[j].x * v[j].x + v[j].y * v[j].y) + (v[j].z * v[j].z + v[j].w * v[j].w);
            const float rs = 1.0f / sqrtf(wave_sum(s) * (1.f / DM) + EPS);
            v2u* o8 = (v2u*)(XN + row * DM) + lane;
#pragma unroll
            for (int j = 0; j < 8; ++j) { const f32x4 y = v[j] * rs * ca[j] + cb[j]; v2u w; w.x = pg8::cvt_pk_bf16(y.x, y.y); w.y = pg8::cvt_pk_bf16(y.z, y.w); o8[64 * j] = w; }
#pragma unroll
            for (int j = 0; j < 8; ++j) v[j] = vn[j];
        }
    }
}

#define GAS __attribute__((address_space(1)))
#define RLX_AGENT __ATOMIC_RELAXED, __HIP_MEMORY_SCOPE_AGENT
#define XB_TMO      128
#define XB_XCNT(j)  (256  + 64 * (j))
#define XB_XSUB(j)  (1280 + 64 * (j))
#define XB_XGEN(j)  (2304 + 64 * (j))
#define XB_TOP      3328
#define XB_TOPGEN   3392
#define XCD_BAR_WORDS 3456
#define XB_SPIN_CAP (1u << 18)

__device__ __forceinline__ unsigned xb_ld(unsigned* p)              { return __hip_atomic_load(p, __ATOMIC_RELAXED, __HIP_MEMORY_SCOPE_AGENT); }
__device__ __forceinline__ unsigned xb_add(unsigned* p, unsigned v) { return __hip_atomic_fetch_add(p, v, __ATOMIC_RELAXED, __HIP_MEMORY_SCOPE_AGENT); }
__device__ __forceinline__ unsigned xb_xcc_id() { return (unsigned)__builtin_amdgcn_s_getreg((3 << 11) | 20) & 0xFu; }
#define XB_SPIN(cond, bar) do { unsigned _sp = 0; while (cond) { __builtin_amdgcn_s_sleep(1); \
    if ((++_sp & 255u) == 0u) { if (xb_ld(&(bar)[XB_TMO])) break; if (_sp > XB_SPIN_CAP) { atomicAdd(&(bar)[XB_TMO], 1u); break; } } } } while (0)

struct XcdBarrier {
    unsigned* bar; unsigned x;
    volatile LAS unsigned* st;
};

__device__ __forceinline__ XcdBarrier xcd_barrier_post(unsigned* bar, volatile LAS unsigned* st) {
    XcdBarrier b; b.bar = bar; b.x = xb_xcc_id(); b.st = st;
    if (threadIdx.x == 0) (void)xb_add(&bar[XB_XCNT(b.x)], 1u);
    return b;
}
__device__ __forceinline__ void xcd_barrier_complete(unsigned* bar, unsigned x, unsigned& nloc, unsigned& nx) {
    const unsigned G = gridDim.x * gridDim.y * gridDim.z;
    unsigned sum, cnt, mine, sp = 0u;
    for (;;) {
        sum = 0u; cnt = 0u; mine = 0u;
#pragma unroll
        for (unsigned j = 0; j < 16; ++j) { const unsigned c = xb_ld(&bar[XB_XCNT(j)]); sum += c; cnt += (c > 0u) ? 1u : 0u; mine = (j == x) ? c : mine; }
        if (sum == G) break;
        __builtin_amdgcn_s_sleep(1);
        if ((++sp & 255u) == 0u) { if (xb_ld(&bar[XB_TMO])) break; if (sp > XB_SPIN_CAP) { atomicAdd(&bar[XB_TMO], 1u); break; } }
    }
    nloc = mine > 0u ? mine : 1u; nx = cnt > 0u ? cnt : 1u;
}

__device__ __forceinline__ void xcd_barrier(const XcdBarrier& b) {
    asm volatile("s_waitcnt vmcnt(0)" ::: "memory");
    __syncthreads();
    if (threadIdx.x == 0) {
        unsigned* bar = b.bar;
        __builtin_amdgcn_s_waitcnt(0);
        unsigned nloc = b.st[0], nx = b.st[1];
        if (nloc == 0u) { xcd_barrier_complete(bar, b.x, nloc, nx); b.st[0] = nloc; b.st[1] = nx; }
        const unsigned old = xb_add(&bar[XB_XSUB(b.x)], 1u);
        const unsigned gen = old / nloc;
        if (old + 1u == (gen + 1u) * nloc) {
            __builtin_amdgcn_fence(__ATOMIC_RELEASE, "agent");
            asm volatile("s_waitcnt vmcnt(0)" ::: "memory");
            const unsigned og = xb_add(&bar[XB_TOP], 1u);
            const unsigned tg = og / nx;
            if (og + 1u == (tg + 1u) * nx) xb_add(&bar[XB_TOPGEN], 1u);
            else XB_SPIN(xb_ld(&bar[XB_TOPGEN]) == tg, bar);
            __builtin_amdgcn_fence(__ATOMIC_ACQUIRE, "agent");
            xb_add(&bar[XB_XGEN(b.x)], 1u);
            asm volatile("s_waitcnt vmcnt(0)" ::: "memory");
        } else {
            XB_SPIN(xb_ld(&bar[XB_XGEN(b.x)]) == gen, bar);
            __builtin_amdgcn_fence(__ATOMIC_ACQUIRE, "agent");
            asm volatile("s_waitcnt vmcnt(0)" ::: "memory");
        }
    }
    __syncthreads();
}

__device__ __forceinline__ const void* kargp(int idx) {
    unsigned long long kp = (unsigned long long)__builtin_amdgcn_kernarg_segment_ptr();
    asm volatile("" : "+s"(kp));
    return ((const void* const __attribute__((address_space(4)))*)kp)[idx];
}
__global__ void __launch_bounds__(NTHR, 2) mega_fwd(Args args) {
    extern __shared__ __attribute__((aligned(16))) unsigned char lds[];
    cg::grid_group grid = cg::this_grid();
    if (threadIdx.x < 32) ((LAS unsigned*)((LAS unsigned char*)lds + MISC_OFF))[threadIdx.x] = 0u;
    __syncthreads();
    XcdBarrier xbar = xcd_barrier_post((unsigned*)((unsigned char*)kargp(25) + WS_CTL), (volatile LAS unsigned*)((LAS unsigned char*)lds + MISC_OFF) + 8);
    grid.sync();
#define GSYNC() xcd_barrier(xbar)
    LAS unsigned char* L = (LAS unsigned char*)lds;
    int tid_k = threadIdx.x;
#define PHASE_IDS() asm volatile("" : "+v"(tid_k)); const int tid = tid_k, lane = tid & 63, wave = __builtin_amdgcn_readfirstlane(tid >> 6), gw = vcu * NWAVES + wave; (void)tid; (void)lane; (void)wave; (void)gw
    const int G = gridDim.x, bx = blockIdx.x;
    const int vcu = (G % 8 == 0) ? (bx % 8) * (G / 8) + bx / 8 : bx;
    const int NGW = G * NWAVES;
#define KARG(T_, i) ((T_)kargp(i))
#define WSP(off) ((bf16*)((unsigned char*)kargp(25) + (off)))
    for (int rep_ = 0; rep_ <= ((DUPM >> 0) & 1); ++rep_) {
    if (PHM & (1 << 0))
    {
        PHASE_IDS();
        const float* cvec = KARG(const float*, 1); const float* ada_w = KARG(const float*, 3); const float* ada_b = KARG(const float*, 4);
        const float* w_in = KARG(const float*, 6); const float* w_conv_out = KARG(const float*, 10); const float* w_attn_out = KARG(const float*, 18); const float* w_out = KARG(const float*, 20);
        const float* w_mlp_in = KARG(const float*, 22); const float* w_mlp_out = KARG(const float*, 23);
        float* ADA = (float*)WSP(WS_ADA); bf16* WIN = WSP(WS_WIN); bf16* WC = WSP(WS_WC); bf16* WA = WSP(WS_WA); bf16* WO = WSP(WS_WO); bf16* W1 = WSP(WS_W1); bf16* W2 = WSP(WS_W2);
        for (int au = bx; au < NADA / 64; au += G) {
            LAS float* cact = (LAS float*)(L + 65536);
            LAS float* part = (LAS float*)(L + 65536 + 32768);
            for (int i = tid; i < BATCH * DM; i += NTHR) { const float v = cvec[i]; cact[i] = v * sigm(v); }
            __syncthreads();
            const int n0 = au * 64, l32 = lane & 31, kh = lane >> 5;
            f32x2 a0 = {0.f, 0.f}, a1 = {0.f, 0.f}, a2 = {0.f, 0.f}, a3 = {0.f, 0.f};
            const float* wp = ada_w + (size_t)(wave * 256 + kh) * NADA + n0 + 2 * l32;
#pragma unroll 16
            for (int k = 0; k < 256; k += 2) { const f32x2 wv = *(const f32x2*)(wp + (size_t)k * NADA); const int kk = wave * 256 + k + kh;
                a0 += wv * cact[kk]; a1 += wv * cact[DM + kk]; a2 += wv * cact[2 * DM + kk]; a3 += wv * cact[3 * DM + kk]; }
            a0.x += __shfl_xor(a0.x, 32); a0.y += __shfl_xor(a0.y, 32); a1.x += __shfl_xor(a1.x, 32); a1.y += __shfl_xor(a1.y, 32);
            a2.x += __shfl_xor(a2.x, 32); a2.y += __shfl_xor(a2.y, 32); a3.x += __shfl_xor(a3.x, 32); a3.y += __shfl_xor(a3.y, 32);
            if (kh == 0) { *(LAS f32x2*)(part + (wave * 4 + 0) * 64 + 2 * l32) = a0; *(LAS f32x2*)(part + (wave * 4 + 1) * 64 + 2 * l32) = a1;
                           *(LAS f32x2*)(part + (wave * 4 + 2) * 64 + 2 * l32) = a2; *(LAS f32x2*)(part + (wave * 4 + 3) * 64 + 2 * l32) = a3; }
            __syncthreads();
            if (tid < 256) { const int b = tid >> 6; float s = ada_b[n0 + lane];
#pragma unroll
                for (int w = 0; w < 8; ++w) s += part[(w * 4 + b) * 64 + lane];
                ADA[b * NADA + n0 + lane] = s; }
            __syncthreads();
        }
        LAS float* scr = (LAS float*)(L + wave * 16640);
        constexpr int I_IN = (DM / 64) * (INW / 64), I_C = (CW / 64) * (DM / 64), I_O = (DM / 64) * (DM / 64), I_1 = (DM / 64) * (FF / 64), I_2 = (FF / 64) * (DM / 64);
        constexpr int NITEMS = I_IN + 2 * I_C + I_O + I_1 + I_2;
        for (int it = gw; it < NITEMS; it += NGW) {
            int r = it;
            if (r < I_IN) { transpose_item(w_in, DM, INW, WIN, scr, r, lane); continue; } r -= I_IN;
            if (r < I_C) { transpose_item(w_conv_out, CW, DM, WC, scr, r, lane); continue; } r -= I_C;
            if (r < I_C) { transpose_item(w_attn_out, CW, DM, WA, scr, r, lane); continue; } r -= I_C;
            if (r < I_O) { transpose_item(w_out, DM, DM, WO, scr, r, lane); continue; } r -= I_O;
            if (r < I_1) { transpose_item(w_mlp_in, DM, FF, W1, scr, r, lane); continue; } r -= I_1;
            transpose_item(w_mlp_out, FF, DM, W2, scr, r, lane);
        }
    }
    GSYNC(); }
    for (int rep_ = 0; rep_ <= ((DUPM >> 1) & 1); ++rep_) {
    if (PHM & (1 << 1)) { PHASE_IDS();
    norm_mod_rows(KARG(const float*, 0), KARG(const float*, 5), (const float*)WSP(WS_ADA), 0, DM, WSP(WS_XN), gw, NGW, lane); }
    GSYNC(); }
    for (int rep_ = 0; rep_ <= ((DUPM >> 2) & 1); ++rep_) {
    if (PHM & (1 << 2))
    {
        bf16* XN = WSP(WS_XN); bf16* WIN = WSP(WS_WIN); bf16* CGb = WSP(WS_CG); bf16* QKR = WSP(WS_QKR); bf16* VH = WSP(WS_VH); bf16* GT = WSP(WS_GT); const float* gate_b = KARG(const float*, 19);
        pg8::Gemm g{XN, WIN, T, INW, DM}; pg8::StaticOrder S; S.init(T, INW, G, bx, WGM_P2);
        pg8::EpiIn E{CGb, QKR, VH, GT, gate_b};
        pg8::gemm_phase<pg8::EpiIn, pg8::StaticOrder, true, true>(L, g, S, E);
    }
    GSYNC(); }
    for (int rep_ = 0; rep_ <= ((DUPM >> 3) & 1); ++rep_) {
    if (PHM & (1 << 3))
    {
        PHASE_IDS();
        const int* pos = KARG(const int*, 2); const float* conv_w = KARG(const float*, 7); const float* conv_b = KARG(const float*, 8); const float* conv_norm_g = KARG(const float*, 9);
        const float* q_norm_g = KARG(const float*, 11); const float* k_norm_g = KARG(const float*, 12);
        bf16* CGb = WSP(WS_CG); bf16* QKR = WSP(WS_QKR); bf16* YC = WSP(WS_YC); bf16* QH = WSP(WS_QH); bf16* KH = WSP(WS_KH);
        LAS unsigned* glu = (LAS unsigned*)L;
        LAS float* red = (LAS float*)L;
        LAS float* tot = (LAS float*)(L + 126976);
        const int c0 = 2 * tid;
        f32x2 wv[31];
#pragma unroll
        for (int j = 0; j < 31; ++j) wv[j] = *(const f32x2*)(conv_w + j * CW + c0);
        const f32x2 cb = *(const f32x2*)(conv_b + c0), cg2 = *(const f32x2*)(conv_norm_g + c0);
        const int upc = (T / 32 + G - 1) / G;
        for (int k = 0; k < upc; ++k) {
            const int unit = vcu * upc + k; if (unit >= T / 32) break;
            const int b = unit >> 8, t0 = (unit & 255) * 32;
            const int row_lo = (k > 0 && t0 != 0) ? 30 : 0;
            for (int idx = tid + row_lo * 128; idx < 62 * 128; idx += NTHR) {
                const int row = idx >> 7, ch8 = idx & 127, srow = t0 - 30 + row; v4u o = {0u, 0u, 0u, 0u};
                if (srow >= 0) { const bf16* p = CGb + (size_t)(b * SEQ + srow) * 2048 + ch8 * 8; const v4u a = *(const v4u*)p, gg = *(const v4u*)(p + 1024);
                    o.x = pg8::cvt_pk_bf16(pg8::bflo(a.x) * pg8::sigmoidf_(pg8::bflo(gg.x)), pg8::bfhi(a.x) * pg8::sigmoidf_(pg8::bfhi(gg.x)));
                    o.y = pg8::cvt_pk_bf16(pg8::bflo(a.y) * pg8::sigmoidf_(pg8::bflo(gg.y)), pg8::bfhi(a.y) * pg8::sigmoidf_(pg8::bfhi(gg.y)));
                    o.z = pg8::cvt_pk_bf16(pg8::bflo(a.z) * pg8::sigmoidf_(pg8::bflo(gg.z)), pg8::bfhi(a.z) * pg8::sigmoidf_(pg8::bfhi(gg.z)));
                    o.w = pg8::cvt_pk_bf16(pg8::bflo(a.w) * pg8::sigmoidf_(pg8::bflo(gg.w)), pg8::bfhi(a.w) * pg8::sigmoidf_(pg8::bfhi(gg.w))); }
                *(LAS v4u*)(glu + row * 512 + ch8 * 4) = o;
            }
            __syncthreads();
            f32x2 y[32];
#pragma unroll
            for (int tg = 0; tg < 4; ++tg) {
#pragma unroll
                for (int i = 0; i < 8; ++i) y[tg * 8 + i] = cb;
#pragma unroll
                for (int r = 0; r < 38; ++r) { const unsigned u = glu[(tg * 8 + r) * 512 + tid]; const f32x2 v = {pg8::bflo(u), pg8::bfhi(u)};
#pragma unroll
                    for (int i = 0; i < 8; ++i) { const int j = r - i; if (j >= 0 && j < 31) y[tg * 8 + i] += wv[j] * v; } }
            }
            __syncthreads();
#pragma unroll
            for (int i = 0; i < 32; ++i) red[i * 512 + tid] = y[i].x * y[i].x + y[i].y * y[i].y;
            __syncthreads();
            { const int tok = tid >> 4, part = tid & 15; float s = 0.f;
#pragma unroll
              for (int k = 0; k < 32; ++k) s += red[tok * 512 + part * 32 + ((k + part) & 31)];
              s += __shfl_xor(s, 1); s += __shfl_xor(s, 2); s += __shfl_xor(s, 4); s += __shfl_xor(s, 8);
              if (part == 0) tot[tok] = s; }
            __syncthreads();
#pragma unroll
            for (int i = 0; i < 32; ++i) { const float rs = __builtin_amdgcn_rsqf(tot[i] * (1.f / CW) + EPS); const f32x2 v = y[i] * rs * cg2;
                *(unsigned*)(YC + (size_t)(b * SEQ + t0 + i) * CW + c0) = pg8::cvt_pk_bf16(v.x * pg8::sigmoidf_(v.x), v.y * pg8::sigmoidf_(v.y)); }
            __syncthreads();
            if (k + 1 < upc) {
                for (int idx = tid; idx < 30 * 128; idx += NTHR) { const int row = idx >> 7, ch8 = idx & 127; *(LAS v4u*)(glu + row * 512 + ch8 * 4) = *(const LAS v4u*)(glu + (row + 32) * 512 + ch8 * 4); }
                __syncthreads();
            }
        }
        {
            const int l16 = lane & 15, tq = lane >> 4;
            f32x4 qg0 = *(const f32x4*)(q_norm_g + 4 * l16), qg1 = *(const f32x4*)(q_norm_g + 64 + 4 * l16), kg0 = *(const f32x4*)(k_norm_g + 4 * l16), kg1 = *(const f32x4*)(k_norm_g + 64 + 4 * l16);
            float invf[4];
#pragma unroll
            for (int e = 0; e < 4; ++e) invf[e] = (float)exp2(-(double)(4 * l16 + e) * (1.0 / 64.0) * 13.287712379549449);
            for (int tg = gw; tg < T / 4; tg += NGW) {
                const int tkn = tg * 4 + tq, b = tkn >> 13, sq = tkn & 8191;
                const float pf = (float)pos[tkn]; float cs[4], sn[4];
#pragma unroll
                for (int e = 0; e < 4; ++e) { const float angf = pf * invf[e]; const double rev = (double)angf * 0.15915494309189535; const float fr = (float)(rev - rint(rev));
                    sn[e] = __builtin_amdgcn_sinf(fr); cs[e] = __builtin_amdgcn_cosf(fr); }
                const bf16* src = QKR + (size_t)tkn * 2048 + 4 * l16;
                v2u r0[16], r1[16];
#pragma unroll
                for (int hm = 0; hm < 16; ++hm) { r0[hm] = *(const v2u*)(src + hm * 128); r1[hm] = *(const v2u*)(src + hm * 128 + 64); }
#pragma unroll
                for (int hm = 0; hm < 16; ++hm) {
                    const f32x4 x1 = {pg8::bflo(r0[hm].x), pg8::bfhi(r0[hm].x), pg8::bflo(r0[hm].y), pg8::bfhi(r0[hm].y)}, x2 = {pg8::bflo(r1[hm].x), pg8::bfhi(r1[hm].x), pg8::bflo(r1[hm].y), pg8::bfhi(r1[hm].y)};
                    float ss = (x1.x * x1.x + x1.y * x1.y) + (x1.z * x1.z + x1.w * x1.w) + (x2.x * x2.x + x2.y * x2.y) + (x2.z * x2.z + x2.w * x2.w);
                    ss += __shfl_xor(ss, 1); ss += __shfl_xor(ss, 2); ss += __shfl_xor(ss, 4); ss += __shfl_xor(ss, 8);
                    const float rs = 1.0f / sqrtf(ss * (1.f / 128.f) + EPS);
                    const f32x4 y1 = x1 * rs * (hm < 8 ? qg0 : kg0), y2 = x2 * rs * (hm < 8 ? qg1 : kg1);
                    bf16* dst = (hm < 8 ? QH : KH) + ((size_t)((b * 8 + (hm & 7)) * SEQ + sq)) * 128 + 4 * l16;
                    v2u o1, o2;
                    o1.x = pg8::cvt_pk_bf16(y1.x * cs[0] - y2.x * sn[0], y1.y * cs[1] - y2.y * sn[1]); o1.y = pg8::cvt_pk_bf16(y1.z * cs[2] - y2.z * sn[2], y1.w * cs[3] - y2.w * sn[3]);
                    o2.x = pg8::cvt_pk_bf16(y2.x * cs[0] + y1.x * sn[0], y2.y * cs[1] + y1.y * sn[1]); o2.y = pg8::cvt_pk_bf16(y2.z * cs[2] + y1.z * sn[2], y2.w * cs[3] + y1.w * sn[3]);
                    *(v2u*)dst = o1; *(v2u*)(dst + 64) = o2;
                }
            }
        }
    }
    GSYNC(); }
    for (int rep_ = 0; rep_ <= ((DUPM >> 4) & 1); ++rep_) {
    if (PHM & (1 << 4))
    {
        PHASE_IDS();
        bf16* QH = WSP(WS_QH); bf16* KH = WSP(WS_KH); bf16* VH = WSP(WS_VH); bf16* O16 = WSP(WS_O16); bf16* OA = WSP(WS_OA);
        att::Seam S;
        const int NSI = BATCH * 4 * 16;
        if (vcu < NSI) {
            int si = vcu, sub = 0;
#define MKREF(R, si_, sub_) do { const int bh_ = (si_) >> 4, j_ = (si_) & 15, b_ = bh_ >> 2, h_ = bh_ & 3, combo_ = (sub_) >> 1, m_ = combo_ >> 1, vh_ = combo_ & 1, qb_ = ((sub_) & 1) ? j_ : 31 - j_;     \
            (R).Q = QH + ((size_t)((b_ * 8 + h_ * 2 + m_) * SEQ + qb_ * 256)) * 128; (R).K = KH + ((size_t)((b_ * 8 + h_ * 2 + m_) * SEQ)) * 128; \
            (R).V = VH + ((size_t)((b_ * 8 + h_ * 2 + vh_) * SEQ)) * 128; (R).O = O16 + ((size_t)((b_ * 16 + h_ * 4 + m_ * 2 + vh_) * SEQ + qb_ * 256)) * 128; (R).P0 = qb_ * 256; } while (0)
            att::BlockRef cur, nxt; MKREF(cur, si, sub);
            att::attn_prime(cur, (char*)lds, S);
            for (;;) {
                int sin = si, subn = sub + 1; bool last = false;
                if (subn == 8) { subn = 0; sin = si + G; if (sin >= NSI) last = true; }
                if (last) nxt = cur; else MKREF(nxt, sin, subn);
                att::attn_block(cur, nxt, (char*)lds, S);
                if (sub == 7) {
                    asm volatile("s_waitcnt vmcnt(0)" ::: "memory"); __syncthreads();
                    float lam;
                    { const float* lq1 = KARG(const float*, 13); const float* lk1 = KARG(const float*, 14); const float* lq2 = KARG(const float*, 15); const float* lk2 = KARG(const float*, 16);
                      lam = __expf(wave_sum(lq1[lane] * lk1[lane] + lq1[lane + 64] * lk1[lane + 64])) - __expf(wave_sum(lq2[lane] * lk2[lane] + lq2[lane + 64] * lk2[lane + 64])) + 0.2f; }
                    const int l16 = lane & 15, rq = lane >> 4;
                    const float* subln_g = KARG(const float*, 17);
                    f32x4 sg[2][2];
#pragma unroll
                    for (int vh = 0; vh < 2; ++vh) { sg[vh][0] = *(const f32x4*)(subln_g + vh * 128 + 8 * l16) * 0.8f; sg[vh][1] = *(const f32x4*)(subln_g + vh * 128 + 8 * l16 + 4) * 0.8f; }
                    const int bh_ = si >> 4, j_ = si & 15, b_ = bh_ >> 2, h_ = bh_ & 3;
                    for (int r0 = wave * 8; r0 < 512; r0 += NWAVES * 8) {
                        v4u uu[2][4];
#pragma unroll
                        for (int q = 0; q < 2; ++q) { const int rr = r0 + q * 4 + rq, s_ = (rr < 256 ? 31 - j_ : j_) * 256 + (rr & 255);
                            const bf16* base = O16 + ((size_t)((b_ * 16 + h_ * 4) * SEQ + s_)) * 128 + 8 * l16;
#pragma unroll
                            for (int c = 0; c < 4; ++c) uu[q][c] = *(const v4u*)(base + (size_t)c * SEQ * 128); }
#pragma unroll
                        for (int q = 0; q < 2; ++q) { const int rr = r0 + q * 4 + rq, s_ = (rr < 256 ? 31 - j_ : j_) * 256 + (rr & 255);
                            float d[2][8]; float ss = 0.f;
#pragma unroll
                            for (int vh = 0; vh < 2; ++vh) { const v4u p = uu[q][vh], n = uu[q][2 + vh];
                                d[vh][0] = pg8::bflo(p.x) - lam * pg8::bflo(n.x); d[vh][1] = pg8::bfhi(p.x) - lam * pg8::bfhi(n.x); d[vh][2] = pg8::bflo(p.y) - lam * pg8::bflo(n.y); d[vh][3] = pg8::bfhi(p.y) - lam * pg8::bfhi(n.y);
                                d[vh][4] = pg8::bflo(p.z) - lam * pg8::bflo(n.z); d[vh][5] = pg8::bfhi(p.z) - lam * pg8::bfhi(n.z); d[vh][6] = pg8::bflo(p.w) - lam * pg8::bflo(n.w); d[vh][7] = pg8::bfhi(p.w) - lam * pg8::bfhi(n.w);
#pragma unroll
                                for (int e = 0; e < 8; ++e) ss += d[vh][e] * d[vh][e]; }
                            ss += __shfl_xor(ss, 1); ss += __shfl_xor(ss, 2); ss += __shfl_xor(ss, 4); ss += __shfl_xor(ss, 8);
                            const float rs = 1.0f / sqrtf(ss * (1.f / 256.f) + EPS);
                            bf16* dst = OA + ((size_t)(b_ * SEQ + s_)) * 1024 + h_ * 256 + 8 * l16;
#pragma unroll
                            for (int vh = 0; vh < 2; ++vh) { v4u o;
                                o.x = pg8::cvt_pk_bf16(d[vh][0] * rs * sg[vh][0].x, d[vh][1] * rs * sg[vh][0].y); o.y = pg8::cvt_pk_bf16(d[vh][2] * rs * sg[vh][0].z, d[vh][3] * rs * sg[vh][0].w);
                                o.z = pg8::cvt_pk_bf16(d[vh][4] * rs * sg[vh][1].x, d[vh][5] * rs * sg[vh][1].y); o.w = pg8::cvt_pk_bf16(d[vh][6] * rs * sg[vh][1].z, d[vh][7] * rs * sg[vh][1].w);
                                *(v4u*)(dst + vh * 128) = o; } }
                    }
                }
                if (last) break;
                cur = nxt; si = sin; sub = subn;
            }
#undef MKREF
        }
    }
    GSYNC(); }
    for (int rep_ = 0; rep_ <= ((DUPM >> 6) & 1); ++rep_) {
    if (PHM & (1 << 6))
    {
        bf16* YC = WSP(WS_YC); bf16* OA = WSP(WS_OA); bf16* WC = WSP(WS_WC); bf16* WA = WSP(WS_WA); bf16* MG = WSP(WS_MG); bf16* GT = WSP(WS_GT);
        pg8::StaticOrder S; S.init(T, DM, G, bx, WGM_P6);
        { pg8::Gemm g{YC, WC, T, DM, CW}; pg8::EpiMerge<false> E{MG, GT}; pg8::gemm_phase<pg8::EpiMerge<false>, pg8::StaticOrder, true, true>(L, g, S, E); }
        { pg8::Gemm g{OA, WA, T, DM, CW}; pg8::EpiMerge<true> E{MG, GT + 2048}; pg8::gemm_phase<pg8::EpiMerge<true>, pg8::StaticOrder, true, true>(L, g, S, E); }
    }
    GSYNC(); }
    for (int rep_ = 0; rep_ <= ((DUPM >> 7) & 1); ++rep_) {
    if (PHM & (1 << 7))
    {
        bf16* MG = WSP(WS_MG); bf16* WO = WSP(WS_WO); const float* x = KARG(const float*, 0); float* out = KARG(float*, 24); const float* ADA = (const float*)WSP(WS_ADA);
        pg8::Gemm g{MG, WO, T, DM, DM}; pg8::StaticOrder S; S.init(T, DM, G, bx, WGM_P7);
        pg8::EpiRes E{x, out, ADA + 2 * DM};
        pg8::gemm_phase<pg8::EpiRes, pg8::StaticOrder, true, true>(L, g, S, E);
    }
    GSYNC(); }
    for (int rep_ = 0; rep_ <= ((DUPM >> 8) & 1); ++rep_) {
    if (PHM & (1 << 8)) { PHASE_IDS();
    norm_mod_rows(KARG(const float*, 24), KARG(const float*, 21), (const float*)WSP(WS_ADA), 3 * DM, 4 * DM, WSP(WS_XN), gw, NGW, lane); }
    GSYNC(); }
    for (int rep_ = 0; rep_ <= ((DUPM >> 9) & 1); ++rep_) {
    if (PHM & (1 << 9))
    {
        bf16* XN = WSP(WS_XN); bf16* W1 = WSP(WS_W1); bf16* HB = WSP(WS_HB);
        pg8::Gemm g{XN, W1, T, FF, DM}; pg8::StaticOrder S; S.init(T, FF, G, bx, WGM_P9);
        pg8::EpiRelu2 E{HB, FF};
        pg8::gemm_phase<pg8::EpiRelu2, pg8::StaticOrder, true, true>(L, g, S, E);
    }
    GSYNC(); }
    if (PHM & (1 << 10))
    {
        bf16* HB = WSP(WS_HB); bf16* W2 = WSP(WS_W2); float* out = KARG(float*, 24); const float* ADA = (const float*)WSP(WS_ADA);
        pg8::Gemm g{HB, W2, T, DM, FF}; pg8::StaticOrder S; S.init(T, DM, G, bx, WGM_P10, REV_P10);
        pg8::EpiRes E{out, out, ADA + 5 * DM};
        pg8::gemm_phase<pg8::EpiRes, pg8::StaticOrder, true, true>(L, g, S, E);
    }
}

extern "C" void kernel_launch(void* const* d_in, const int* in_sizes, int n_in, void* d_out, int out_size, void* d_ws, size_t ws_size, hipStream_t stream) {
    static int grid = 0;
    if (grid == 0) {
        if (n_in != 24 || in_sizes[0] != T * DM || out_size != T * DM || ws_size < WS_END) { fprintf(stderr, "kernel_launch: unexpected shapes (n_in %d, in0 %d, out %d, ws %zu)\n", n_in, n_in > 0 ? in_sizes[0] : -1, out_size, ws_size); grid = -1; return; }
        int dev = 0, cus = 0, per_cu = 0;
        (void)hipGetDevice(&dev); (void)hipDeviceGetAttribute(&cus, hipDeviceAttributeMultiprocessorCount, dev);
        if (hipFuncSetAttribute((const void*)mega_fwd, hipFuncAttributeMaxDynamicSharedMemorySize, LDS_BYTES) != hipSuccess) { fprintf(stderr, "kernel_launch: hipFuncSetAttribute failed\n"); grid = -1; return; }
        if (hipOccupancyMaxActiveBlocksPerMultiprocessor(&per_cu, (const void*)mega_fwd, NTHR, LDS_BYTES) != hipSuccess || per_cu < 1) { fprintf(stderr, "kernel_launch: occupancy query says %d\n", per_cu); per_cu = 1; }
        (void)hipGetLastError();
        grid = cus * 1;
        if (grid <= 0) grid = 256;
    }
    if (grid < 0) return;
    if (hipMemsetAsync((char*)d_ws + WS_CTL, 0, CTL_BYTES, stream) != hipSuccess) { fprintf(stderr, "kernel_launch: memset failed\n"); return; }
    Args a{};
    for (int i = 0; i < 24; ++i) a.in[i] = d_in[i];
    a.out = (float*)d_out; a.ws = (unsigned char*)d_ws;
    void* params[] = {&a};
    hipError_t e = hipLaunchCooperativeKernel((const void*)mega_fwd, dim3(grid), dim3(NTHR), params, LDS_BYTES, stream);
    if (e != hipSuccess) fprintf(stderr, "kernel_launch: cooperative launch failed: %s (grid %d)\n", hipGetErrorString(e), grid);
}
```

```cpp
#include <hip/hip_runtime.h>
#include <hip/hip_cooperative_groups.h>
#include <cstdio>
#include <cstdint>
#include <cmath>
namespace pg8 {
#define PG8_LAS __attribute__((address_space(3)))
typedef unsigned short bf16_t;
typedef short bf16x8 __attribute__((ext_vector_type(8)));
typedef float f32x4 __attribute__((ext_vector_type(4)));
typedef unsigned u32x4 __attribute__((ext_vector_type(4)));
constexpr int BM = 256, BK = 64, HALF = 128, HTB = HALF * BK * 2  , STAGE_BYTES = 8 * HTB, NXCD = 8, WGM = 4;

__host__ __device__ __forceinline__ int lds_byte(int r, int c) { const int st = (r >> 4) * 2 + (c >> 5), rr = r & 15, cc = c & 31, ob = rr * 64 + cc * 2; return st * 1024 + (ob ^ (((ob >> 9) & 1) << 5)); }
__host__ __device__ __forceinline__ void stage_rc(int b, int& R, int& C) { const int st = b / 1024, sb = b % 1024, swz = sb ^ (((sb >> 9) & 1) << 5); R = (st >> 1) * 16 + swz / 64; C = (st & 1) * 32 + (swz % 64) / 2; }
__host__ __device__ __forceinline__ int perm32(int rho) { const int n = rho >> 4, i = rho & 15; return 8 * (i >> 2) + 4 * n + (i & 3); }

struct Unit { int pm, pn; };
struct Gemm { const bf16_t* A; const bf16_t* Bt; int M, N, K; };

struct StaticOrder {
    int nM, nN, nwg, G, c, wgm, rev;
    __host__ __device__ void init(int M, int N, int G_, int c_, int wgm_ = WGM, int rev_ = 0) { nM = M / BM; nN = N / BM; nwg = nM * nN; G = G_; c = c_; wgm = wgm_; rev = rev_; }
    __host__ __device__ bool next(int i, Unit& u) const {
        const long L = (long)i * G + c; if (L >= nwg) return false;
        int wgid = (int)L; { const int q = nwg / NXCD, r = nwg % NXCD, xcd = wgid % NXCD, off = wgid / NXCD; wgid = (xcd < r ? xcd * (q + 1) : r * (q + 1) + (xcd - r) * q) + off; }
        const int nig = wgm * nN, gid = wgid / nig, fm = gid * wgm, gsz = (nM - fm) < wgm ? (nM - fm) : wgm;
        u.pm = fm + ((wgid % nig) % gsz); u.pn = (wgid % nig) / gsz; if (rev) u.pm = nM - 1 - u.pm; return true;
    }
    __device__ __forceinline__ void a_ready(const Unit&) const {}
    __device__ __forceinline__ void done(const Unit&) const {}
};


typedef float f32x2_t __attribute__((ext_vector_type(2))); typedef __bf16 bf16x2_t __attribute__((ext_vector_type(2)));
__device__ __forceinline__ unsigned cvt_pk_bf16(float lo, float hi) { f32x2_t v = {lo, hi}; bf16x2_t b = __builtin_convertvector(v, bf16x2_t); return __builtin_bit_cast(unsigned, b); }
__device__ __forceinline__ float bflo(unsigned w) { return __uint_as_float(w << 16); }
__device__ __forceinline__ float bfhi(unsigned w) { return __uint_as_float(w & 0xffff0000u); }
__device__ __forceinline__ float sigmoidf_(float x) { return __builtin_amdgcn_rcpf(1.0f + __expf(-x)); }
__device__ __forceinline__ u32x4 pack8f(f32x4 v0, f32x4 v1) { u32x4 w; w.x = cvt_pk_bf16(v0[0], v0[1]); w.y = cvt_pk_bf16(v0[2], v0[3]); w.z = cvt_pk_bf16(v1[0], v1[1]); w.w = cvt_pk_bf16(v1[2], v1[3]); return w; }

struct EpiIn {
    static constexpr bool PERM = true, AFTER_DRAIN = false;
    bf16_t* CG; bf16_t* QK; bf16_t* VH; bf16_t* GT; const float* gate_b;
    __device__ __forceinline__ void operator()(const f32x4 (&acc)[2][2][4][2], const Unit& u, int wr, int wc, int fr, int fq) const {
        const int row0 = u.pm * BM + wr * 64 + fr, cin = wc * 32 + 8 * fq, pn = u.pn;
        if (pn < 16) {
            bf16_t* base = (pn < 8 ? CG + pn * BM : QK + (pn - 8) * BM) + cin;
#pragma unroll
            for (int ai = 0; ai < 2; ++ai)
#pragma unroll
                for (int m = 0; m < 4; ++m) { bf16_t* rowp = base + (size_t)(row0 + ai * HALF + m * 16) * 2048;
#pragma unroll
                    for (int bj = 0; bj < 2; ++bj) *(u32x4*)(rowp + bj * HALF) = pack8f(acc[ai][bj][m][0], acc[ai][bj][m][1]); }
        } else if (pn < 20) {
            const int h = pn - 16;
#pragma unroll
            for (int ai = 0; ai < 2; ++ai)
#pragma unroll
                for (int m = 0; m < 4; ++m) { const int r = row0 + ai * HALF + m * 16, b = r >> 13, s = r & 8191;
#pragma unroll
                    for (int bj = 0; bj < 2; ++bj) *(u32x4*)(VH + ((size_t)((b * 8 + h * 2 + bj) * 8192 + s)) * 128 + cin) = pack8f(acc[ai][bj][m][0], acc[ai][bj][m][1]); }
        } else {
            const int c0 = (pn - 20) * BM + cin;
            f32x4 bv[2][2];
#pragma unroll
            for (int bj = 0; bj < 2; ++bj)
#pragma unroll
                for (int n = 0; n < 2; ++n) bv[bj][n] = *(const f32x4*)(gate_b + c0 + bj * HALF + 4 * n);
#pragma unroll
            for (int ai = 0; ai < 2; ++ai)
#pragma unroll
                for (int m = 0; m < 4; ++m) { bf16_t* rowp = GT + (size_t)(row0 + ai * HALF + m * 16) * 4096 + c0;
#pragma unroll
                    for (int bj = 0; bj < 2; ++bj) { f32x4 v0 = acc[ai][bj][m][0] + bv[bj][0], v1 = acc[ai][bj][m][1] + bv[bj][1];
#pragma unroll
                        for (int e = 0; e < 4; ++e) { v0[e] = sigmoidf_(v0[e]); v1[e] = sigmoidf_(v1[e]); }
                        *(u32x4*)(rowp + bj * HALF) = pack8f(v0, v1); } }
        }
    }
};
template <bool ADD> struct EpiMerge {
    static constexpr bool PERM = true, AFTER_DRAIN = false;
    bf16_t* MG; const bf16_t* G;
    __device__ __forceinline__ void operator()(const f32x4 (&acc)[2][2][4][2], const Unit& u, int wr, int wc, int fr, int fq) const {
        const int row0 = u.pm * BM + wr * 64 + fr, c0 = u.pn * BM + wc * 32 + 8 * fq;
#pragma unroll
        for (int ai = 0; ai < 2; ++ai) {
            u32x4 gg[4][2], oo[4][2];
#pragma unroll
            for (int m = 0; m < 4; ++m) { const size_t r = (size_t)(row0 + ai * HALF + m * 16);
#pragma unroll
                for (int bj = 0; bj < 2; ++bj) { gg[m][bj] = *(const u32x4*)(G + r * 4096 + c0 + bj * HALF); if (ADD) oo[m][bj] = *(const u32x4*)(MG + r * 2048 + c0 + bj * HALF); } }
#pragma unroll
            for (int m = 0; m < 4; ++m) { const size_t r = (size_t)(row0 + ai * HALF + m * 16);
#pragma unroll
                for (int bj = 0; bj < 2; ++bj) { const u32x4 g = gg[m][bj]; bf16_t* op = MG + r * 2048 + c0 + bj * HALF;
                    f32x4 v0 = acc[ai][bj][m][0], v1 = acc[ai][bj][m][1];
                    v0[0] *= bflo(g.x); v0[1] *= bfhi(g.x); v0[2] *= bflo(g.y); v0[3] *= bfhi(g.y); v1[0] *= bflo(g.z); v1[1] *= bfhi(g.z); v1[2] *= bflo(g.w); v1[3] *= bfhi(g.w);
                    if (ADD) { const u32x4 o = oo[m][bj]; v0[0] += bflo(o.x); v0[1] += bfhi(o.x); v0[2] += bflo(o.y); v0[3] += bfhi(o.y); v1[0] += bflo(o.z); v1[1] += bfhi(o.z); v1[2] += bflo(o.w); v1[3] += bfhi(o.w); }
                    *(u32x4*)op = pack8f(v0, v1); } }
        }
    }
};
struct EpiRes {
    static constexpr bool PERM = false, AFTER_DRAIN = false;
    const float* base; float* out; const float* gate;
    __device__ __forceinline__ void operator()(const f32x4 (&acc)[2][2][4][2], const Unit& u, int wr, int wc, int fr, int fq) const {
        const int row0 = u.pm * BM + wr * 64 + fr, c0 = u.pn * BM + wc * 32 + 4 * fq; const float* gp = gate + (size_t)(u.pm >> 5) * 12288 + c0;
        f32x4 gv[2][2];
#pragma unroll
        for (int bj = 0; bj < 2; ++bj)
#pragma unroll
            for (int n = 0; n < 2; ++n) gv[bj][n] = *(const f32x4*)(gp + bj * HALF + n * 16);
#pragma unroll
        for (int ai = 0; ai < 2; ++ai) {
            f32x4 bs[4][2][2];
#pragma unroll
            for (int m = 0; m < 4; ++m) { const size_t off = (size_t)(row0 + ai * HALF + m * 16) * 2048 + c0;
#pragma unroll
                for (int bj = 0; bj < 2; ++bj)
#pragma unroll
                    for (int n = 0; n < 2; ++n) bs[m][bj][n] = *(const f32x4*)(base + off + bj * HALF + n * 16); }
#pragma unroll
            for (int m = 0; m < 4; ++m) { const size_t off = (size_t)(row0 + ai * HALF + m * 16) * 2048 + c0;
#pragma unroll
                for (int bj = 0; bj < 2; ++bj)
#pragma unroll
                    for (int n = 0; n < 2; ++n) *(f32x4*)(out + off + bj * HALF + n * 16) = bs[m][bj][n] + gv[bj][n] * acc[ai][bj][m][n]; }
        }
    }
};
struct EpiRelu2 {
    static constexpr bool PERM = true, AFTER_DRAIN = false;
    bf16_t* O; int ldc;
    __device__ __forceinline__ void operator()(const f32x4 (&acc)[2][2][4][2], const Unit& u, int wr, int wc, int fr, int fq) const {
        const int row0 = u.pm * BM + wr * 64 + fr, c0 = u.pn * BM + wc * 32 + 8 * fq;
#pragma unroll
        for (int ai = 0; ai < 2; ++ai)
#pragma unroll
            for (int m = 0; m < 4; ++m) { bf16_t* rowp = O + (size_t)(row0 + ai * HALF + m * 16) * ldc + c0;
#pragma unroll
                for (int bj = 0; bj < 2; ++bj) { f32x4 v0 = acc[ai][bj][m][0], v1 = acc[ai][bj][m][1];
#pragma unroll
                    for (int e = 0; e < 4; ++e) { const float a = fmaxf(v0[e], 0.f), b = fmaxf(v1[e], 0.f); v0[e] = a * a; v1[e] = b * b; }
                    *(u32x4*)(rowp + bj * HALF) = pack8f(v0, v1); } }
    }
};

template <class Epi, class Sched, bool ALIGN_EPI = false, bool SP2 = false>
__device__ __forceinline__ void gemm_phase(PG8_LAS unsigned char* lds, const Gemm g, const Sched& S, const Epi& E) {
    int tid_ = threadIdx.x; asm volatile("" : "+v"(tid_));
    const int tid = tid_, wid = __builtin_amdgcn_readfirstlane(tid >> 6), lane = tid & 63, wr = wid >> 2, wc = wid & 3, fr = lane & 15, fq = lane >> 4;
    const int K = g.K, nt = K / BK;
    unsigned voffA[2], voffB[2];
#pragma unroll
    for (int i = 0; i < 2; ++i) { int R, C; stage_rc(tid * 16 + i * 8192, R, C); const int Rb = Epi::PERM ? ((R & ~31) + perm32(R & 31)) : R;
        voffA[i] = (unsigned)(R * K + C) * 2u; voffB[i] = (unsigned)(Rb * K + C) * 2u; }
    const size_t kstep = (size_t)(BK * 2);
    const size_t hstep = (size_t)HALF * K * 2;
    const size_t tstep = 2 * hstep;
    const unsigned ldsw = (unsigned)wid * 1024u;
    const int aoff = lds_byte(wr * 64 + fr, fq * 8), boff = lds_byte(wc * 32 + fr, fq * 8);
#define PG8_SA(b, h) (((b) * 2 + (h)) * HTB)
#define PG8_SB(b, h) ((4 + (b) * 2 + (h)) * HTB)
#define PG8_STAGE(bufoff, gbase, voff) do { _Pragma("unroll") for (int _i = 0; _i < 2; ++_i) \
        __builtin_amdgcn_global_load_lds((const unsigned*)((const char*)(gbase) + (voff)[_i]), (PG8_LAS unsigned*)(lds + (bufoff) + ldsw + _i * 8192), 16, 0, 0); } while (0)
#define PG8_LDA(dst, b, h) do { _Pragma("unroll") for (int m = 0; m < 4; ++m) _Pragma("unroll") for (int k = 0; k < 2; ++k) dst[m][k] = *(const PG8_LAS bf16x8*)(lds + PG8_SA(b, h) + aoff + m * 2048 + k * 1024); } while (0)
#define PG8_LDB(dst, b, h) do { _Pragma("unroll") for (int n = 0; n < 2; ++n) _Pragma("unroll") for (int k = 0; k < 2; ++k) dst[n][k] = *(const PG8_LAS bf16x8*)(lds + PG8_SB(b, h) + boff + n * 2048 + k * 1024); } while (0)
#define PG8_MMA(ai, bj, At, Bt) do { __builtin_amdgcn_s_setprio(1); _Pragma("unroll") for (int m = 0; m < 4; ++m) _Pragma("unroll") for (int n = 0; n < 2; ++n) _Pragma("unroll") for (int k = 0; k < 2; ++k) \
        acc[ai][bj][m][n] = __builtin_amdgcn_mfma_f32_16x16x32_bf16(Bt[n][k], At[m][k], acc[ai][bj][m][n], 0, 0, 0); __builtin_amdgcn_s_setprio(0); } while (0)
#define PG8_WAIT_V(n) asm volatile("s_waitcnt vmcnt(" #n ")" ::: "memory")
#define PG8_WAIT_L(n) asm volatile("s_waitcnt lgkmcnt(" #n ")" ::: "memory")
#define PG8_BAR __builtin_amdgcn_s_barrier()
#define PG8_SCHED __builtin_amdgcn_sched_barrier(0)
    Unit cur, nxt; int ui = 0;
    if (!S.next(0, cur)) return;
    f32x4 acc[2][2][4][2];
#pragma unroll
    for (int a = 0; a < 2; ++a)
#pragma unroll
        for (int b = 0; b < 2; ++b)
#pragma unroll
            for (int m = 0; m < 4; ++m)
#pragma unroll
                for (int n = 0; n < 2; ++n) acc[a][b][m][n] = (f32x4){0.f, 0.f, 0.f, 0.f};
    bf16x8 At[4][2], B0[2][2], B1[2][2];
    const char* cA = (const char*)g.A + (size_t)cur.pm * tstep; const char* cB = (const char*)g.Bt + (size_t)cur.pn * tstep;
    S.a_ready(cur);
    if constexpr (SP2) {
        PG8_STAGE(PG8_SB(0, 0), cB, voffB); PG8_STAGE(PG8_SB(0, 1), cB + hstep, voffB); PG8_STAGE(PG8_SA(0, 0), cA, voffA); PG8_STAGE(PG8_SA(0, 1), cA + hstep, voffA);
        if (wr == 1) PG8_BAR;
        PG8_WAIT_V(2); PG8_BAR;
        PG8_STAGE(PG8_SB(1, 0), cB + kstep, voffB); PG8_STAGE(PG8_SA(1, 0), cA + kstep, voffA); PG8_STAGE(PG8_SB(1, 1), cB + hstep + kstep, voffB);
        PG8_WAIT_V(6); PG8_BAR;
    } else {
        PG8_STAGE(PG8_SB(0, 0), cB, voffB); PG8_STAGE(PG8_SA(0, 0), cA, voffA); PG8_STAGE(PG8_SB(0, 1), cB + hstep, voffB); PG8_STAGE(PG8_SA(0, 1), cA + hstep, voffA);
        if (wr == 1) PG8_BAR;
        PG8_WAIT_V(4); PG8_BAR;
        PG8_STAGE(PG8_SB(1, 0), cB + kstep, voffB); PG8_STAGE(PG8_SA(1, 0), cA + kstep, voffA); PG8_STAGE(PG8_SB(1, 1), cB + hstep + kstep, voffB);
        PG8_WAIT_V(6); PG8_BAR;
    }
    for (;;) {
        const bool has_next = S.next(ui + 1, nxt);
        const char* nA = has_next ? (const char*)g.A + (size_t)nxt.pm * tstep : cA; const char* nB = has_next ? (const char*)g.Bt + (size_t)nxt.pn * tstep : cB;
        for (int t = 0; t < nt; t += 2) {
            const bool last = (t == nt - 2);
            const char* a1 = cA + (size_t)(t + 1) * kstep;
            const char* a2 = last ? nA : cA + (size_t)(t + 2) * kstep; const char* b2 = last ? nB : cB + (size_t)(t + 2) * kstep;
            const char* a3 = a2 + kstep; const char* b3 = b2 + kstep;
            if (last && has_next) S.a_ready(nxt);
            if constexpr (SP2) {
            PG8_LDB(B0, 0, 0); PG8_LDB(B1, 0, 1); PG8_SCHED; PG8_LDA(At, 0, 0); PG8_STAGE(PG8_SA(1, 1), a1 + hstep, voffA);
            PG8_WAIT_V(8); PG8_WAIT_L(0); PG8_BAR; PG8_MMA(0, 0, At, B0); PG8_MMA(0, 1, At, B1); PG8_BAR; PG8_SCHED;
            PG8_LDA(At, 0, 1); PG8_STAGE(PG8_SB(0, 0), b2, voffB); PG8_STAGE(PG8_SB(0, 1), b2 + hstep, voffB); PG8_STAGE(PG8_SA(0, 0), a2, voffA);
            PG8_WAIT_V(8); PG8_WAIT_L(0); PG8_BAR; PG8_MMA(1, 0, At, B0); PG8_MMA(1, 1, At, B1); PG8_BAR; PG8_SCHED;
            PG8_LDB(B0, 1, 0); PG8_LDB(B1, 1, 1); PG8_SCHED; PG8_LDA(At, 1, 0); PG8_STAGE(PG8_SA(0, 1), a2 + hstep, voffA);
            PG8_WAIT_V(8); PG8_WAIT_L(0); PG8_BAR; PG8_MMA(0, 0, At, B0); PG8_MMA(0, 1, At, B1); PG8_BAR; PG8_SCHED;
            PG8_LDA(At, 1, 1); PG8_STAGE(PG8_SB(1, 0), b3, voffB); PG8_STAGE(PG8_SB(1, 1), b3 + hstep, voffB); PG8_STAGE(PG8_SA(1, 0), a3, voffA);
            PG8_WAIT_V(8); PG8_WAIT_L(0); PG8_BAR; PG8_MMA(1, 0, At, B0); PG8_MMA(1, 1, At, B1); PG8_BAR; PG8_SCHED;
            } else {
            PG8_LDB(B0, 0, 0); PG8_SCHED; PG8_LDA(At, 0, 0); PG8_STAGE(PG8_SA(1, 1), a1 + hstep, voffA);
            PG8_WAIT_L(8); PG8_BAR; PG8_WAIT_L(0); PG8_MMA(0, 0, At, B0); PG8_BAR; PG8_SCHED;
            PG8_LDB(B1, 0, 1); PG8_STAGE(PG8_SB(0, 0), b2, voffB);
            PG8_BAR; PG8_WAIT_L(0); PG8_MMA(0, 1, At, B1); PG8_BAR;
            PG8_LDA(At, 0, 1); PG8_STAGE(PG8_SA(0, 0), a2, voffA);
            PG8_BAR; PG8_WAIT_L(0); PG8_MMA(1, 0, At, B0); PG8_BAR; PG8_SCHED;
            PG8_STAGE(PG8_SB(0, 1), b2 + hstep, voffB);
            PG8_WAIT_V(6); PG8_BAR; PG8_MMA(1, 1, At, B1); PG8_BAR;
            PG8_LDB(B0, 1, 0); PG8_SCHED; PG8_LDA(At, 1, 0); PG8_STAGE(PG8_SA(0, 1), a2 + hstep, voffA);
            PG8_WAIT_L(8); PG8_BAR; PG8_WAIT_L(0); PG8_MMA(0, 0, At, B0); PG8_BAR; PG8_SCHED;
            PG8_LDB(B1, 1, 1); PG8_STAGE(PG8_SB(1, 0), b3, voffB);
            PG8_BAR; PG8_WAIT_L(0); PG8_MMA(0, 1, At, B1); PG8_BAR;
            PG8_LDA(At, 1, 1); PG8_STAGE(PG8_SA(1, 0), a3, voffA);
            PG8_BAR; PG8_WAIT_L(0); PG8_MMA(1, 0, At, B0); PG8_BAR; PG8_SCHED;
            PG8_STAGE(PG8_SB(1, 1), b3 + hstep, voffB);
            PG8_WAIT_V(6); PG8_BAR; PG8_MMA(1, 1, At, B1); PG8_BAR;
            }
        }
        if constexpr (ALIGN_EPI) { if (wr == 0) PG8_BAR; }
        if constexpr (!Epi::AFTER_DRAIN) { E(acc, cur, wr, wc, fr, fq); S.done(cur); }
        if (!has_next) break;
#pragma unroll
        for (int a = 0; a < 2; ++a)
#pragma unroll
            for (int b = 0; b < 2; ++b)
#pragma unroll
                for (int m = 0; m < 4; ++m)
#pragma unroll
                    for (int n = 0; n < 2; ++n) acc[a][b][m][n] = (f32x4){0.f, 0.f, 0.f, 0.f};
        cur = nxt; cA = nA; cB = nB; ++ui;
        if constexpr (ALIGN_EPI) { if (wr == 1) PG8_BAR; }
    }
    PG8_WAIT_V(0);
    if constexpr (!ALIGN_EPI) { if (wr == 0) PG8_BAR; }
    PG8_BAR;
    if constexpr (Epi::AFTER_DRAIN) { E.fused(acc, cur, wr, wc, fr, fq, lds, wid, lane); S.done(cur); }
#undef PG8_SA
#undef PG8_SB
#undef PG8_STAGE
#undef PG8_LDA
#undef PG8_LDB
#undef PG8_MMA
#undef PG8_WAIT_V
#undef PG8_WAIT_L
#undef PG8_BAR
#undef PG8_SCHED
}
}

namespace att {
constexpr int D = 128;
constexpr float SCALE = 0.08838834764831845f;
constexpr float THR = 8.f;
constexpr int NW = 8, QBLK = 32, KVBLK = 64, QB = NW * QBLK;
constexpr int SHM_V = KVBLK * D * 2, SHM_K = KVBLK * D * 2;
constexpr int LDS_BYTES = 2 * SHM_V + 2 * SHM_K + NW * 64 * 4;
typedef unsigned short bf16;
typedef short bf16x8 __attribute__((ext_vector_type(8)));
typedef short s16x4 __attribute__((ext_vector_type(4)));
typedef float f32x16 __attribute__((ext_vector_type(16)));
typedef float f32x4 __attribute__((ext_vector_type(4)));
typedef unsigned u32x4 __attribute__((ext_vector_type(4)));
#define KSWZ(row, colB) ((row) * 256 + ((colB) ^ (((row) & 7) << 4)))
#define SBAR() __builtin_amdgcn_sched_barrier(0)
__device__ __forceinline__ int v_st(int k, int c) { const int kk = (k & ~0xC) | ((k & 4) << 1) | ((k & 8) >> 1); return ((kk >> 3) * 4 + (c >> 5)) * 512 + ((kk & 7) * 32 + (c & 31)) * 2; }
__device__ __forceinline__ int v_rd_base(int lane) { return ((lane & 3) << 3) | (((lane >> 2) & 3) << 6) | (((lane >> 4) & 1) << 5) | (((lane >> 5) & 1) << 8); }
constexpr int v_rd_off(int d0, int ks, int half) { return d0 * 512 + ks * 4096 + half * 2048; }
__device__ __forceinline__ int crow(int r, int hi) { return (r & 3) + 8 * (r >> 2) + 4 * hi; }
__device__ __forceinline__ unsigned cvtpk(float lo, float hi) { return pg8::cvt_pk_bf16(lo, hi); }
__device__ __forceinline__ bf16x8 load8(const bf16* p) { return *reinterpret_cast<const bf16x8*>(p); }
__device__ __forceinline__ void partialSM(f32x16& p0, f32x16& p1, float& m_reg, float& mn, float& alpha) {
    float pmax = p0[0]; for (int r = 1; r < 16; ++r) pmax = fmaxf(pmax, p0[r]); for (int r = 0; r < 16; ++r) pmax = fmaxf(pmax, p1[r]);
    { auto rr = __builtin_amdgcn_permlane32_swap(__float_as_uint(pmax), __float_as_uint(pmax), false, false);
      pmax = fmaxf(__uint_as_float(rr[0]), __uint_as_float(rr[1])); }
    constexpr float C2 = 1.4426950408889634f * SCALE;
    if (__builtin_expect(__all((pmax - m_reg) * SCALE <= THR), 1)) { mn = m_reg; alpha = 1.f; }
    else { mn = fmaxf(m_reg, pmax); alpha = __builtin_amdgcn_exp2f((m_reg - mn) * C2); m_reg = mn; }
    const float mnL = -mn * C2;
    for (int r = 0; r < 16; ++r) p0[r] = fmaf(p0[r], C2, mnL); for (int r = 0; r < 16; ++r) p1[r] = fmaf(p1[r], C2, mnL);
    for (int r = 0; r < 16; ++r) p0[r] = __builtin_amdgcn_exp2f(p0[r]);
}
__device__ __forceinline__ void finishSM(f32x16& p0, f32x16& p1, float alpha, float& l_reg, bf16x8& pa0, bf16x8& pa1, bf16x8& pa2, bf16x8& pa3) {
    for (int r = 0; r < 16; ++r) p1[r] = __builtin_amdgcn_exp2f(p1[r]);
    float ps = 0; for (int r = 0; r < 16; ++r) ps += p0[r]; for (int r = 0; r < 16; ++r) ps += p1[r];
    { auto rr = __builtin_amdgcn_permlane32_swap(__float_as_uint(ps), __float_as_uint(ps), false, false);
      ps = __uint_as_float(rr[0]) + __uint_as_float(rr[1]); }
    l_reg = l_reg * alpha + ps;
#define PK4(P, B_, OUT) do { unsigned a0 = cvtpk(P[B_+0], P[B_+1]), a1 = cvtpk(P[B_+2], P[B_+3]);                          \
        unsigned b0 = cvtpk(P[B_+4], P[B_+5]), b1 = cvtpk(P[B_+6], P[B_+7]);                                             \
        auto r0 = __builtin_amdgcn_permlane32_swap(a0, b0, false, false); auto r1 = __builtin_amdgcn_permlane32_swap(a1, b1, false, false); \
        u32x4 w = {r0[0], r1[0], r0[1], r1[1]}; OUT = *reinterpret_cast<bf16x8*>(&w); } while (0)
    PK4(p0, 0, pa0); PK4(p0, 8, pa1); PK4(p1, 0, pa2); PK4(p1, 8, pa3);
#undef PK4
}
template <int KB>
__device__ __forceinline__ void qkt(f32x16& p0, f32x16& p1, const char* K_lds, int r32, int hi, const bf16x8* qr) {
    p0 = f32x16{}; p1 = f32x16{};
    const char* kb[4];
#pragma unroll
    for (int dd = 0; dd < 4; ++dd) kb[dd] = K_lds + KB * SHM_K + KSWZ(r32, (dd * 16 + hi * 8) * 2);
#pragma unroll
    for (int d0 = 0; d0 < 8; ++d0) { const char* a = kb[d0 & 3] + (d0 >> 2) * 128;
        bf16x8 b0 = *reinterpret_cast<const bf16x8*>(a);
        bf16x8 b1 = *reinterpret_cast<const bf16x8*>(a + 32 * 256);
        p0 = __builtin_amdgcn_mfma_f32_32x32x16_bf16(b0, qr[d0], p0, 0, 0, 0);
        p1 = __builtin_amdgcn_mfma_f32_32x32x16_bf16(b1, qr[d0], p1, 0, 0, 0); }
}
template <int VB>
__device__ __forceinline__ void pv_tile(f32x16* o, int vb0, bf16x8 pa0, bf16x8 pa1, bf16x8 pa2, bf16x8 pa3) {
#define TRRD(dst, off) asm volatile("ds_read_b64_tr_b16 %0, %1 offset:%2" : "=&v"(dst) : "v"(vb0), "i"(off) : "memory")
#define PV_D0(d0) do { s16x4 l0, l1, l2, l3, h0, h1, h2, h3; constexpr int b_ = VB * SHM_V + v_rd_off(d0, 0, 0); \
        TRRD(l0, b_); TRRD(h0, b_ + 2048); TRRD(l1, b_ + 4096); TRRD(h1, b_ + 6144); TRRD(l2, b_ + 8192); TRRD(h2, b_ + 10240); TRRD(l3, b_ + 12288); TRRD(h3, b_ + 14336); \
        asm volatile("s_waitcnt lgkmcnt(0)" ::: "memory"); SBAR(); \
        o[d0] = __builtin_amdgcn_mfma_f32_32x32x16_bf16(pa0, (bf16x8){l0[0], l0[1], l0[2], l0[3], h0[0], h0[1], h0[2], h0[3]}, o[d0], 0, 0, 0);   \
        o[d0] = __builtin_amdgcn_mfma_f32_32x32x16_bf16(pa1, (bf16x8){l1[0], l1[1], l1[2], l1[3], h1[0], h1[1], h1[2], h1[3]}, o[d0], 0, 0, 0);   \
        o[d0] = __builtin_amdgcn_mfma_f32_32x32x16_bf16(pa2, (bf16x8){l2[0], l2[1], l2[2], l2[3], h2[0], h2[1], h2[2], h2[3]}, o[d0], 0, 0, 0);   \
        o[d0] = __builtin_amdgcn_mfma_f32_32x32x16_bf16(pa3, (bf16x8){l3[0], l3[1], l3[2], l3[3], h3[0], h3[1], h3[2], h3[3]}, o[d0], 0, 0, 0); } while (0)
    PV_D0(0); PV_D0(1); PV_D0(2); PV_D0(3);
#undef PV_D0
#undef TRRD
}
struct BlockRef { const bf16* Q; const bf16* K; const bf16* V; bf16* O; int P0; };
struct Seam { bf16x8 qr[8]; bf16x8 st_v0, st_v1, st_k0, st_k1; };
#define ROW(p, k0, rr) ((p) + (size_t)((k0) + (rr)) * D + sc)
#define VMW() asm volatile("s_waitcnt vmcnt(0)" ::: "memory")
#define VMWN(n) asm volatile("s_waitcnt vmcnt(%0)" :: "i"(n) : "memory")
#define SLOAD_H(Kp, Vp, k0) do { S.st_v0 = load8(ROW(Vp, k0, sr)); S.st_v1 = load8(ROW(Vp, k0, 32 + sr)); S.st_k0 = load8(ROW(Kp, k0, sr)); S.st_k1 = load8(ROW(Kp, k0, 32 + sr)); } while (0)
#define SWRITE_HK(bf) do { *(bf16x8*)(K_lds + (bf) * SHM_K + kws) = S.st_k0; *(bf16x8*)(K_lds + (bf) * SHM_K + kws + 32 * 256) = S.st_k1; } while (0)
#define SWRITE_HV(bf) do { *(bf16x8*)(V_lds + (bf) * SHM_V + vst0) = S.st_v0; *(bf16x8*)(V_lds + (bf) * SHM_V + vst1) = S.st_v1; } while (0)
#define SWRITE_H(bf) do { SWRITE_HV(bf); SWRITE_HK(bf); } while (0)
__device__ __forceinline__ void attn_prime(const BlockRef& cur, char* lds, Seam& S) {
    int tid_ = threadIdx.x; asm volatile("" : "+v"(tid_));
    const int tid = tid_, wid = __builtin_amdgcn_readfirstlane(tid >> 6), lane = tid & 63, r32 = lane & 31, hi = lane >> 5;
    const int sr = tid >> 4, sc = (tid & 15) * 8, kws = KSWZ(sr, sc * 2); char* K_lds = lds + 2 * SHM_V;
    for (int d0 = 0; d0 < 8; ++d0) S.qr[d0] = load8(cur.Q + (size_t)(wid * QBLK + r32) * D + d0 * 16 + hi * 8);
    SLOAD_H(cur.K, cur.V, 0); VMW(); SWRITE_HK(0);
    __syncthreads();
}
__device__ __forceinline__ void attn_block(const BlockRef& cur, const BlockRef& nxt, char* lds, Seam& S) {
    int tid_ = threadIdx.x; asm volatile("" : "+v"(tid_));
    const int tid = tid_, wid = __builtin_amdgcn_readfirstlane(tid >> 6), lane = tid & 63, r32 = lane & 31, hi = lane >> 5;
    const int NT = (cur.P0 + QB) / KVBLK;
    const int qlo = cur.P0 + wid * QBLK;
    char* V_lds = lds; char* K_lds = lds + 2 * SHM_V;
    float* ws = (float*)(lds + 2 * SHM_V + 2 * SHM_K) + wid * 64; float* li_l = ws, * al_l = ws + 32;
    float m_reg = -1e30f, l_reg = 0; f32x16 o[4] = {};
    const int sr = tid >> 4, sc = (tid & 15) * 8, vst0 = v_st(sr, sc), vst1 = v_st(32 + sr, sc), kws = KSWZ(sr, sc * 2);
    const int vb0 = (int)(uintptr_t)V_lds + v_rd_base(lane);
    const bf16* Kh = cur.K; const bf16* Vh = cur.V;
#define RESC(a) do { if (__any((a) < 1.f)) { if (hi == 0) al_l[r32] = (a); asm volatile("s_waitcnt lgkmcnt(0)" ::: "memory");              \
                     for (int d_ = 0; d_ < 4; ++d_) for (int r = 0; r < 16; ++r) o[d_][r] *= al_l[crow(r, hi)]; } } while (0)
#define KBASE(t) ((t) * KVBLK)
#define MASKT(P0_, P1_, t) do { if (KBASE(t) > (qlo | 63)) { const float NEG_ = -__builtin_inff(); _Pragma("unroll") for (int r_ = 0; r_ < 16; ++r_) { P0_[r_] = NEG_; P1_[r_] = NEG_; } } } while (0)
    constexpr int NQL = 8;
#define SEAM_K0() do { VMWN(NQL); SWRITE_HK(0); SBAR(); } while (0)
    f32x16 pA0, pA1, pB0, pB1; float mnA, mnB, alA, alB; bf16x8 pa0, pa1, pa2, pa3;
    SWRITE_HV(0); SBAR();
    if (NT > 1) { SLOAD_H(Kh, Vh, KBASE(1)); }
    SBAR(); qkt<0>(pA0, pA1, K_lds, r32, hi, S.qr);
    MASKT(pA0, pA1, 0); partialSM(pA0, pA1, m_reg, mnA, alA);
    if (NT > 1) { VMW(); SWRITE_H(1); }
    __syncthreads();
#define HALF_STEP(PX0, PX1, mnX, alX, PY0, PY1, alY, t, KB, VB, SB) do {                                                      \
        SBAR(); qkt<KB>(PX0, PX1, K_lds, r32, hi, S.qr);                                                                      \
        finishSM(PY0, PY1, alY, l_reg, pa0, pa1, pa2, pa3); SBAR();                                                           \
        if ((t) + 1 < NT) { SLOAD_H(Kh, Vh, KBASE((t) + 1)); SBAR(); }                                                        \
        pv_tile<VB>(o, vb0, pa0, pa1, pa2, pa3); MASKT(PX0, PX1, (t)); partialSM(PX0, PX1, m_reg, mnX, alX);                  \
        __syncthreads();                                                                                                      \
        if ((t) + 1 < NT) { VMW(); SWRITE_H(SB); }                                                                            \
        RESC(alX); __syncthreads(); } while (0)
    for (int t = 1; t + 1 < NT; t += 2) {
        HALF_STEP(pB0, pB1, mnB, alB, pA0, pA1, alA, t, 1, 0, 0);
        HALF_STEP(pA0, pA1, mnA, alA, pB0, pB1, alB, t + 1, 0, 1, 1);
    }
    const bool even = (NT & 1) == 0;
    const bool actL = KBASE(NT - 1) <= (qlo | 63), actP = KBASE(NT - 2) <= (qlo | 63);
    if (even) { SBAR(); if (actL) qkt<1>(pB0, pB1, K_lds, r32, hi, S.qr); else { const float NEG_ = -__builtin_inff(); _Pragma("unroll") for (int r_ = 0; r_ < 16; ++r_) { pB0[r_] = NEG_; pB1[r_] = NEG_; } } SBAR(); }
    { const int sr_ = sr; (void)sr_; SLOAD_H(nxt.K, nxt.V, 0); SBAR();
#pragma unroll
      for (int d0 = 0; d0 < 8; ++d0) S.qr[d0] = load8(nxt.Q + (size_t)(wid * QBLK + r32) * D + d0 * 16 + hi * 8); }
    SBAR();
    finishSM(pA0, pA1, alA, l_reg, pa0, pa1, pa2, pa3); SBAR();
    if (actP) pv_tile<0>(o, vb0, pa0, pa1, pa2, pa3);
    if (even) { MASKT(pB0, pB1, NT - 1); partialSM(pB0, pB1, m_reg, mnB, alB); __syncthreads(); RESC(alB);
        finishSM(pB0, pB1, alB, l_reg, pa0, pa1, pa2, pa3); SBAR(); if (actL) pv_tile<1>(o, vb0, pa0, pa1, pa2, pa3); }
    SBAR(); SEAM_K0();
    if (hi == 0) li_l[r32] = l_reg; asm volatile("s_waitcnt lgkmcnt(0)" ::: "memory");
    float rli[16];
#pragma unroll
    for (int r = 0; r < 16; ++r) rli[r] = __builtin_amdgcn_rcpf(li_l[crow(r, hi)]);
    bf16* Ow = cur.O + (size_t)(wid * QBLK) * D;
#pragma unroll
    for (int r = 0; r < 16; ++r) { const int orow = crow(r, hi);
#pragma unroll
        for (int d0 = 0; d0 < 4; ++d0) { const float v = o[d0][r] * rli[r];
            const float vn = __shfl_xor(v, 1);
            if ((r32 & 1) == 0) *(unsigned*)(Ow + (size_t)orow * D + d0 * 32 + r32) = cvtpk(v, vn); } }
    __syncthreads();
#undef RESC
#undef KBASE
#undef MASKT
#undef SEAM_K0
#undef HALF_STEP
}
#undef ROW
#undef VMW
#undef VMWN
#undef SLOAD_H
#undef SWRITE_HK
#undef SWRITE_HV
#undef SWRITE_H
#undef SBAR
#undef KSWZ
}

#ifndef WGM_P2
#define WGM_P2 4
#endif
#ifndef WGM_P9
#define WGM_P9 8
#endif
#ifndef REV_P10
#define REV_P10 0
#endif
#ifndef PHM
#define PHM 0xFFFF
#endif
#ifndef DUPM
#define DUPM 0
#endif
namespace cg = cooperative_groups;
#define LAS __attribute__((address_space(3)))
typedef unsigned short bf16;
typedef unsigned v4u __attribute__((ext_vector_type(4)));
typedef unsigned v2u __attribute__((ext_vector_type(2)));
typedef float f32x4 __attribute__((ext_vector_type(4)));
typedef float f32x2 __attribute__((ext_vector_type(2)));

constexpr int NWAVES = 8, NTHR = 512;
constexpr int BATCH = 4, SEQ = 8192, DM = 2048, T = BATCH * SEQ, FF = 8192, INW = 9216, CW = 1024, NADA = 6 * DM;
constexpr float EPS = 1e-6f;
constexpr size_t MiB = 1u << 20;
constexpr size_t WS_ADA = 0, WS_WIN = 2 * MiB, WS_WC = 38 * MiB, WS_WA = 42 * MiB, WS_WO = 46 * MiB, WS_W1 = 54 * MiB, WS_W2 = 86 * MiB;
constexpr size_t WS_XN = 120 * MiB, WS_CG = 248 * MiB, WS_O16 = 248 * MiB, WS_QKR = 376 * MiB, WS_OA = 376 * MiB, WS_GT = 504 * MiB;
constexpr size_t WS_QH = 760 * MiB, WS_KH = 824 * MiB, WS_VH = 888 * MiB, WS_MG = 760 * MiB, WS_YC = 952 * MiB, WS_HB = 248 * MiB, WS_END = 1016 * MiB;
constexpr int LDS_BYTES = 147456;
constexpr int MISC_OFF = 147456 - 256;
constexpr size_t WS_CTL = 1 * MiB, CTL_BYTES = 16384;

struct Args { const void* in[24]; float* out; unsigned char* ws; };

__device__ __forceinline__ float bf2f(unsigned short u) { return __uint_as_float((unsigned)u << 16); }
__device__ __forceinline__ float wave_sum(float v) {
#pragma unroll
    for (int o = 1; o < 64; o <<= 1) v += __shfl_xor(v, o);
    return v;
}
__device__ __forceinline__ float sigm(float x) { return 1.0f / (1.0f + __expf(-x)); }

__device__ __forceinline__ void transpose_item(const float* W, int K, int N, bf16* WT, LAS float* scr, int item, int lane) {
    const int nblk = N / 64, kb = item / nblk, nb = item % nblk, k0 = 64 * kb, n0 = 64 * nb;
    f32x4 v[16];
#pragma unroll
    for (int i = 0; i < 16; ++i) v[i] = __builtin_nontemporal_load((const f32x4*)(W + (size_t)(k0 + 4 * i + (lane >> 4)) * N + n0 + (lane & 15) * 4));
#pragma unroll
    for (int i = 0; i < 16; ++i) { LAS float* d = scr + (4 * i + (lane >> 4)) * 65 + (lane & 15) * 4; d[0] = v[i].x; d[1] = v[i].y; d[2] = v[i].z; d[3] = v[i].w; }
    asm volatile("s_waitcnt lgkmcnt(0)" ::: "memory");
    const int c = lane & 7;
#pragma unroll
    for (int j = 0; j < 8; ++j) { const int n = (lane >> 3) + 8 * j; const LAS float* s = scr + (8 * c) * 65 + n;
        v4u o; o.x = pg8::cvt_pk_bf16(s[0 * 65], s[1 * 65]); o.y = pg8::cvt_pk_bf16(s[2 * 65], s[3 * 65]); o.z = pg8::cvt_pk_bf16(s[4 * 65], s[5 * 65]); o.w = pg8::cvt_pk_bf16(s[6 * 65], s[7 * 65]);
        *(v4u*)(WT + (size_t)(n0 + n) * K + k0 + 8 * c) = o; }
    asm volatile("s_waitcnt lgkmcnt(0)" ::: "memory");
}

__device__ __forceinline__ void norm_mod_rows(const float* x, const float* g, const float* ada, int shift_off, int scale_off, bf16* XN, int gw, int NGW, int lane) {
    for (int chunk = gw; chunk < T / 16; chunk += NGW) {
        const int b = (chunk * 16) >> 13;
        f32x4 ca[8], cb[8];
#pragma unroll
        for (int j = 0; j < 8; ++j) { const int c = (lane + 64 * j) * 4; const f32x4 gg = *(const f32x4*)(g + c), sc = *(const f32x4*)(ada + b * NADA + scale_off + c);
            ca[j] = gg * (sc + 1.0f); cb[j] = *(const f32x4*)(ada + b * NADA + shift_off + c); }
        f32x4 v[8], vn[8];
        { const f32x4* xr = (const f32x4*)(x + (size_t)chunk * 16 * DM) + lane;
#pragma unroll
          for (int j = 0; j < 8; ++j) v[j] = __builtin_nontemporal_load(xr + 64 * j); }
        for (int i = 0; i < 16; ++i) {
            const size_t row = (size_t)chunk * 16 + i;
            { const f32x4* xr = (const f32x4*)(x + (row + (i < 15 ? 1 : 0)) * DM) + lane;
#pragma unroll
              for (int j = 0; j < 8; ++j) vn[j] = __builtin_nontemporal_load(xr + 64 * j); }
            float s = 0.f;
#pragma unroll
            for (int j = 0; j < 8; ++j) s += (v[j].x * v[j].x + v[j].y * v[j].y) + (v[j].z * v[j].z + v[j].w * v[j].w);
            const float rs = 1.0f / sqrtf(wave_sum(s) * (1.f / DM) + EPS);
            v2u* o8 = (v2u*)(XN + row * DM) + lane;
#pragma unroll
            for (int j = 0; j < 8; ++j) { const f32x4 y = v[j] * rs * ca[j] + cb[j]; v2u w; w.x = pg8::cvt_pk_bf16(y.x, y.y); w.y = pg8::cvt_pk_bf16(y.z, y.w); o8[64 * j] = w; }
#pragma unroll
            for (int j = 0; j < 8; ++j) v[j] = vn[j];
        }
    }
}

#define GAS __attribute__((address_space(1)))
#define RLX_AGENT __ATOMIC_RELAXED, __HIP_MEMORY_SCOPE_AGENT
#define XB_TMO      128
#define XB_XCNT(j)  (256  + 64 * (j))
#define XB_XSUB(j)  (1280 + 64 * (j))
#define XB_XGEN(j)  (2304 + 64 * (j))
#define XB_TOP      3328
#define XB_TOPGEN   3392
#define XCD_BAR_WORDS 3456
#define XB_SPIN_CAP (1u << 18)

__device__ __forceinline__ unsigned xb_ld(unsigned* p)              { return __hip_atomic_load(p, __ATOMIC_RELAXED, __HIP_MEMORY_SCOPE_AGENT); }
__device__ __forceinline__ unsigned xb_add(unsigned* p, unsigned v) { return __hip_atomic_fetch_add(p, v, __ATOMIC_RELAXED, __HIP_MEMORY_SCOPE_AGENT); }
__device__ __forceinline__ unsigned xb_xcc_id() { return (unsigned)__builtin_amdgcn_s_getreg((3 << 11) | 20) & 0xFu; }
#define XB_SPIN(cond, bar) do { unsigned _sp = 0; while (cond) { __builtin_amdgcn_s_sleep(1); \
    if ((++_sp & 255u) == 0u) { if (xb_ld(&(bar)[XB_TMO])) break; if (_sp > XB_SPIN_CAP) { atomicAdd(&(bar)[XB_TMO], 1u); break; } } } } while (0)

struct XcdBarrier {
    unsigned* bar; unsigned x;
    volatile LAS unsigned* st;
};

__device__ __forceinline__ XcdBarrier xcd_barrier_post(unsigned* bar, volatile LAS unsigned* st) {
    XcdBarrier b; b.bar = bar; b.x = xb_xcc_id(); b.st = st;
    if (threadIdx.x == 0) (void)xb_add(&bar[XB_XCNT(b.x)], 1u);
    return b;
}
__device__ __forceinline__ void xcd_barrier_complete(unsigned* bar, unsigned x, unsigned& nloc, unsigned& nx) {
    const unsigned G = gridDim.x * gridDim.y * gridDim.z;
    unsigned sum, cnt, mine, sp = 0u;
    for (;;) {
        sum = 0u; cnt = 0u; mine = 0u;
#pragma unroll
        for (unsigned j = 0; j < 16; ++j) { const unsigned c = xb_ld(&bar[XB_XCNT(j)]); sum += c; cnt += (c > 0u) ? 1u : 0u; mine = (j == x) ? c : mine; }
        if (sum == G) break;
        __builtin_amdgcn_s_sleep(1);
        if ((++sp & 255u) == 0u) { if (xb_ld(&bar[XB_TMO])) break; if (sp > XB_SPIN_CAP) { atomicAdd(&bar[XB_TMO], 1u); break; } }
    }
    nloc = mine > 0u ? mine : 1u; nx = cnt > 0u ? cnt : 1u;
}

__device__ __forceinline__ void xcd_barrier(const XcdBarrier& b) {
    asm volatile("s_waitcnt vmcnt(0)" ::: "memory");
    __syncthreads();
    if (threadIdx.x == 0) {
        unsigned* bar = b.bar;
        __builtin_amdgcn_s_waitcnt(0);
        unsigned nloc = b.st[0], nx = b.st[1];
        if (nloc == 0u) { xcd_barrier_complete(bar, b.x, nloc, nx); b.st[0] = nloc; b.st[1] = nx; }
        const unsigned old = xb_add(&bar[XB_XSUB(b.x)], 1u);
        const unsigned gen = old / nloc;
        if (old + 1u == (gen + 1u) * nloc) {
            __builtin_amdgcn_fence(__ATOMIC_RELEASE, "agent");
            asm volatile("s_waitcnt vmcnt(0)" ::: "memory");
            const unsigned og = xb_add(&bar[XB_TOP], 1u);
            const unsigned tg = og / nx;
            if (og + 1u == (tg + 1u) * nx) xb_add(&bar[XB_TOPGEN], 1u);
            else XB_SPIN(xb_ld(&bar[XB_TOPGEN]) == tg, bar);
            __builtin_amdgcn_fence(__ATOMIC_ACQUIRE, "agent");
            xb_add(&bar[XB_XGEN(b.x)], 1u);
            asm volatile("s_waitcnt vmcnt(0)" ::: "memory");
        } else {
            XB_SPIN(xb_ld(&bar[XB_XGEN(b.x)]) == gen, bar);
            __builtin_amdgcn_fence(__ATOMIC_ACQUIRE, "agent");
            asm volatile("s_waitcnt vmcnt(0)" ::: "memory");
        }
    }
    __syncthreads();
}

__device__ __forceinline__ const void* kargp(int idx) {
    unsigned long long kp = (unsigned long long)__builtin_amdgcn_kernarg_segment_ptr();
    asm volatile("" : "+s"(kp));
    return ((const void* const __attribute__((address_space(4)))*)kp)[idx];
}
__global__ void __launch_bounds__(NTHR, 2) mega_fwd(Args args) {
    extern __shared__ __attribute__((aligned(16))) unsigned char lds[];
    cg::grid_group grid = cg::this_grid();
    if (threadIdx.x < 32) ((LAS unsigned*)((LAS unsigned char*)lds + MISC_OFF))[threadIdx.x] = 0u;
    __syncthreads();
    XcdBarrier xbar = xcd_barrier_post((unsigned*)((unsigned char*)kargp(25) + WS_CTL), (volatile LAS unsigned*)((LAS unsigned char*)lds + MISC_OFF) + 8);
    grid.sync();
#define GSYNC() xcd_barrier(xbar)
    LAS unsigned char* L = (LAS unsigned char*)lds;
    int tid_k = threadIdx.x;
#define PHASE_IDS() asm volatile("" : "+v"(tid_k)); const int tid = tid_k, lane = tid & 63, wave = __builtin_amdgcn_readfirstlane(tid >> 6), gw = vcu * NWAVES + wave; (void)tid; (void)lane; (void)wave; (void)gw
    const int G = gridDim.x, bx = blockIdx.x;
    const int vcu = (G % 8 == 0) ? (bx % 8) * (G / 8) + bx / 8 : bx;
    const int NGW = G * NWAVES;
#define KARG(T_, i) ((T_)kargp(i))
#define WSP(off) ((bf16*)((unsigned char*)kargp(25) + (off)))
    for (int rep_ = 0; rep_ <= ((DUPM >> 0) & 1); ++rep_) {
    if (PHM & (1 << 0))
    {
        PHASE_IDS();
        const float* cvec = KARG(const float*, 1); const float* ada_w = KARG(const float*, 3); const float* ada_b = KARG(const float*, 4);
        const float* w_in = KARG(const float*, 6); const float* w_conv_out = KARG(const float*, 10); const float* w_attn_out = KARG(const float*, 18); const float* w_out = KARG(const float*, 20);
        const float* w_mlp_in = KARG(const float*, 22); const float* w_mlp_out = KARG(const float*, 23);
        float* ADA = (float*)WSP(WS_ADA); bf16* WIN = WSP(WS_WIN); bf16* WC = WSP(WS_WC); bf16* WA = WSP(WS_WA); bf16* WO = WSP(WS_WO); bf16* W1 = WSP(WS_W1); bf16* W2 = WSP(WS_W2);
        for (int au = bx; au < NADA / 64; au += G) {
            LAS float* cact = (LAS float*)(L + 65536);
            LAS float* part = (LAS float*)(L + 65536 + 32768);
            for (int i = tid; i < BATCH * DM; i += NTHR) { const float v = cvec[i]; cact[i] = v * sigm(v); }
            __syncthreads();
            const int n0 = au * 64, l32 = lane & 31, kh = lane >> 5;
            f32x2 a0 = {0.f, 0.f}, a1 = {0.f, 0.f}, a2 = {0.f, 0.f}, a3 = {0.f, 0.f};
            const float* wp = ada_w + (size_t)(wave * 256 + kh) * NADA + n0 + 2 * l32;
#pragma unroll 16
            for (int k = 0; k < 256; k += 2) { const f32x2 wv = __builtin_nontemporal_load((const f32x2*)(wp + (size_t)k * NADA)); const int kk = wave * 256 + k + kh;
                a0 += wv * cact[kk]; a1 += wv * cact[DM + kk]; a2 += wv * cact[2 * DM + kk]; a3 += wv * cact[3 * DM + kk]; }
            a0.x += __shfl_xor(a0.x, 32); a0.y += __shfl_xor(a0.y, 32); a1.x += __shfl_xor(a1.x, 32); a1.y += __shfl_xor(a1.y, 32);
            a2.x += __shfl_xor(a2.x, 32); a2.y += __shfl_xor(a2.y, 32); a3.x += __shfl_xor(a3.x, 32); a3.y += __shfl_xor(a3.y, 32);
            if (kh == 0) { *(LAS f32x2*)(part + (wave * 4 + 0) * 64 + 2 * l32) = a0; *(LAS f32x2*)(part + (wave * 4 + 1) * 64 + 2 * l32) = a1;
                           *(LAS f32x2*)(part + (wave * 4 + 2) * 64 + 2 * l32) = a2; *(LAS f32x2*)(part + (wave * 4 + 3) * 64 + 2 * l32) = a3; }
            __syncthreads();
            if (tid < 256) { const int b = tid >> 6; float s = ada_b[n0 + lane];
#pragma unroll
                for (int w = 0; w < 8; ++w) s += part[(w * 4 + b) * 64 + lane];
                ADA[b * NADA + n0 + lane] = s; }
            __syncthreads();
        }
        LAS float* scr = (LAS float*)(L + wave * 16640);
        constexpr int I_IN = (DM / 64) * (INW / 64), I_C = (CW / 64) * (DM / 64), I_O = (DM / 64) * (DM / 64), I_1 = (DM / 64) * (FF / 64), I_2 = (FF / 64) * (DM / 64);
        constexpr int NITEMS = I_IN + 2 * I_C + I_O + I_1 + I_2;
        for (int it = gw; it < NITEMS; it += NGW) {
            int r = it;
            if (r < I_IN) { transpose_item(w_in, DM, INW, WIN, scr, r, lane); continue; } r -= I_IN;
            if (r < I_C) { transpose_item(w_conv_out, CW, DM, WC, scr, r, lane); continue; } r -= I_C;
            if (r < I_C) { transpose_item(w_attn_out, CW, DM, WA, scr, r, lane); continue; } r -= I_C;
            if (r < I_O) { transpose_item(w_out, DM, DM, WO, scr, r, lane); continue; } r -= I_O;
            if (r < I_1) { transpose_item(w_mlp_in, DM, FF, W1, scr, r, lane); continue; } r -= I_1;
            transpose_item(w_mlp_out, FF, DM, W2, scr, r, lane);
        }
    }
    GSYNC(); }
    for (int rep_ = 0; rep_ <= ((DUPM >> 1) & 1); ++rep_) {
    if (PHM & (1 << 1)) { PHASE_IDS();
    norm_mod_rows(KARG(const float*, 0), KARG(const float*, 5), (const float*)WSP(WS_ADA), 0, DM, WSP(WS_XN), gw, NGW, lane); }
    GSYNC(); }
    for (int rep_ = 0; rep_ <= ((DUPM >> 2) & 1); ++rep_) {
    if (PHM & (1 << 2))
    {
        bf16* XN = WSP(WS_XN); bf16* WIN = WSP(WS_WIN); bf16* CGb = WSP(WS_CG); bf16* QKR = WSP(WS_QKR); bf16* VH = WSP(WS_VH); bf16* GT = WSP(WS_GT); const float* gate_b = KARG(const float*, 19);
        pg8::Gemm g{XN, WIN, T, INW, DM}; pg8::StaticOrder S; S.init(T, INW, G, bx, WGM_P2);
        pg8::EpiIn E{CGb, QKR, VH, GT, gate_b};
        pg8::gemm_phase<pg8::EpiIn, pg8::StaticOrder, true, true>(L, g, S, E);
    }
    GSYNC(); }
    for (int rep_ = 0; rep_ <= ((DUPM >> 3) & 1); ++rep_) {
    if (PHM & (1 << 3))
    {
        PHASE_IDS();
        const int* pos = KARG(const int*, 2); const float* conv_w = KARG(const float*, 7); const float* conv_b = KARG(const float*, 8); const float* conv_norm_g = KARG(const float*, 9);
        const float* q_norm_g = KARG(const float*, 11); const float* k_norm_g = KARG(const float*, 12);
        bf16* CGb = WSP(WS_CG); bf16* QKR = WSP(WS_QKR); bf16* YC = WSP(WS_YC); bf16* QH = WSP(WS_QH); bf16* KH = WSP(WS_KH);
        LAS unsigned* glu = (LAS unsigned*)L;
        LAS float* red = (LAS float*)L;
        LAS float* tot = (LAS float*)(L + 126976);
        const int c0 = 2 * tid;
        f32x2 wv[31];
#pragma unroll
        for (int j = 0; j < 31; ++j) wv[j] = *(const f32x2*)(conv_w + j * CW + c0);
        const f32x2 cb = *(const f32x2*)(conv_b + c0), cg2 = *(const f32x2*)(conv_norm_g + c0);
        const int upc = (T / 32 + G - 1) / G;
        for (int k = 0; k < upc; ++k) {
            const int unit = vcu * upc + k; if (unit >= T / 32) break;
            const int b = unit >> 8, t0 = (unit & 255) * 32;
            const int row_lo = (k > 0 && t0 != 0) ? 30 : 0;
            for (int idx = tid + row_lo * 128; idx < 62 * 128; idx += NTHR) {
                const int row = idx >> 7, ch8 = idx & 127, srow = t0 - 30 + row; v4u o = {0u, 0u, 0u, 0u};
                if (srow >= 0) { const bf16* p = CGb + (size_t)(b * SEQ + srow) * 2048 + ch8 * 8; const v4u a = *(const v4u*)p, gg = *(const v4u*)(p + 1024);
                    o.x = pg8::cvt_pk_bf16(pg8::bflo(a.x) * pg8::sigmoidf_(pg8::bflo(gg.x)), pg8::bfhi(a.x) * pg8::sigmoidf_(pg8::bfhi(gg.x)));
                    o.y = pg8::cvt_pk_bf16(pg8::bflo(a.y) * pg8::sigmoidf_(pg8::bflo(gg.y)), pg8::bfhi(a.y) * pg8::sigmoidf_(pg8::bfhi(gg.y)));
                    o.z = pg8::cvt_pk_bf16(pg8::bflo(a.z) * pg8::sigmoidf_(pg8::bflo(gg.z)), pg8::bfhi(a.z) * pg8::sigmoidf_(pg8::bfhi(gg.z)));
                    o.w = pg8::cvt_pk_bf16(pg8::bflo(a.w) * pg8::sigmoidf_(pg8::bflo(gg.w)), pg8::bfhi(a.w) * pg8::sigmoidf_(pg8::bfhi(gg.w))); }
                *(LAS v4u*)(glu + row * 512 + ch8 * 4) = o;
            }
            __syncthreads();
            f32x2 y[32];
#pragma unroll
            for (int tg = 0; tg < 4; ++tg) {
#pragma unroll
                for (int i = 0; i < 8; ++i) y[tg * 8 + i] = cb;
#pragma unroll
                for (int r = 0; r < 38; ++r) { const unsigned u = glu[(tg * 8 + r) * 512 + tid]; const f32x2 v = {pg8::bflo(u), pg8::bfhi(u)};
#pragma unroll
                    for (int i = 0; i < 8; ++i) { const int j = r - i; if (j >= 0 && j < 31) y[tg * 8 + i] += wv[j] * v; } }
            }
            __syncthreads();
#pragma unroll
            for (int i = 0; i < 32; ++i) red[i * 512 + tid] = y[i].x * y[i].x + y[i].y * y[i].y;
            __syncthreads();
            { const int tok = tid >> 4, part = tid & 15; float s = 0.f;
#pragma unroll
              for (int k = 0; k < 32; ++k) s += red[tok * 512 + part * 32 + ((k + part) & 31)];
              s += __shfl_xor(s, 1); s += __shfl_xor(s, 2); s += __shfl_xor(s, 4); s += __shfl_xor(s, 8);
              if (part == 0) tot[tok] = s; }
            __syncthreads();
#pragma unroll
            for (int i = 0; i < 32; ++i) { const float rs = __builtin_amdgcn_rsqf(tot[i] * (1.f / CW) + EPS); const f32x2 v = y[i] * rs * cg2;
                *(unsigned*)(YC + (size_t)(b * SEQ + t0 + i) * CW + c0) = pg8::cvt_pk_bf16(v.x * pg8::sigmoidf_(v.x), v.y * pg8::sigmoidf_(v.y)); }
            __syncthreads();
            if (k + 1 < upc) {
                for (int idx = tid; idx < 30 * 128; idx += NTHR) { const int row = idx >> 7, ch8 = idx & 127; *(LAS v4u*)(glu + row * 512 + ch8 * 4) = *(const LAS v4u*)(glu + (row + 32) * 512 + ch8 * 4); }
                __syncthreads();
            }
        }
        {
            const int l16 = lane & 15, tq = lane >> 4;
            f32x4 qg0 = *(const f32x4*)(q_norm_g + 4 * l16), qg1 = *(const f32x4*)(q_norm_g + 64 + 4 * l16), kg0 = *(const f32x4*)(k_norm_g + 4 * l16), kg1 = *(const f32x4*)(k_norm_g + 64 + 4 * l16);
            float invf[4];
#pragma unroll
            for (int e = 0; e < 4; ++e) invf[e] = (float)exp2(-(double)(4 * l16 + e) * (1.0 / 64.0) * 13.287712379549449);
            for (int tg = gw; tg < T / 4; tg += NGW) {
                const int tkn = tg * 4 + tq, b = tkn >> 13, sq = tkn & 8191;
                const float pf = (float)pos[tkn]; float cs[4], sn[4];
#pragma unroll
                for (int e = 0; e < 4; ++e) { const float angf = pf * invf[e]; const double rev = (double)angf * 0.15915494309189535; const float fr = (float)(rev - rint(rev));
                    sn[e] = __builtin_amdgcn_sinf(fr); cs[e] = __builtin_amdgcn_cosf(fr); }
                const bf16* src = QKR + (size_t)tkn * 2048 + 4 * l16;
                v2u r0[16], r1[16];
#pragma unroll
                for (int hm = 0; hm < 16; ++hm) { r0[hm] = *(const v2u*)(src + hm * 128); r1[hm] = *(const v2u*)(src + hm * 128 + 64); }
#pragma unroll
                for (int hm = 0; hm < 16; ++hm) {
                    const f32x4 x1 = {pg8::bflo(r0[hm].x), pg8::bfhi(r0[hm].x), pg8::bflo(r0[hm].y), pg8::bfhi(r0[hm].y)}, x2 = {pg8::bflo(r1[hm].x), pg8::bfhi(r1[hm].x), pg8::bflo(r1[hm].y), pg8::bfhi(r1[hm].y)};
                    float ss = (x1.x * x1.x + x1.y * x1.y) + (x1.z * x1.z + x1.w * x1.w) + (x2.x * x2.x + x2.y * x2.y) + (x2.z * x2.z + x2.w * x2.w);
                    ss += __shfl_xor(ss, 1); ss += __shfl_xor(ss, 2); ss += __shfl_xor(ss, 4); ss += __shfl_xor(ss, 8);
                    const float rs = 1.0f / sqrtf(ss * (1.f / 128.f) + EPS);
                    const f32x4 y1 = x1 * rs * (hm < 8 ? qg0 : kg0), y2 = x2 * rs * (hm < 8 ? qg1 : kg1);
                    bf16* dst = (hm < 8 ? QH : KH) + ((size_t)((b * 8 + (hm & 7)) * SEQ + sq)) * 128 + 4 * l16;
                    v2u o1, o2;
                    o1.x = pg8::cvt_pk_bf16(y1.x * cs[0] - y2.x * sn[0], y1.y * cs[1] - y2.y * sn[1]); o1.y = pg8::cvt_pk_bf16(y1.z * cs[2] - y2.z * sn[2], y1.w * cs[3] - y2.w * sn[3]);
                    o2.x = pg8::cvt_pk_bf16(y2.x * cs[0] + y1.x * sn[0], y2.y * cs[1] + y1.y * sn[1]); o2.y = pg8::cvt_pk_bf16(y2.z * cs[2] + y1.z * sn[2], y2.w * cs[3] + y1.w * sn[3]);
                    *(v2u*)dst = o1; *(v2u*)(dst + 64) = o2;
                }
            }
        }
    }
    GSYNC(); }
    for (int rep_ = 0; rep_ <= ((DUPM >> 4) & 1); ++rep_) {
    if (PHM & (1 << 4))
    {
        PHASE_IDS();
        bf16* QH = WSP(WS_QH); bf16* KH = WSP(WS_KH); bf16* VH = WSP(WS_VH); bf16* O16 = WSP(WS_O16); bf16* OA = WSP(WS_OA);
        att::Seam S;
        const int NSI = BATCH * 4 * 16;
        if (vcu < NSI) {
            int si = vcu, sub = 0;
#define MKREF(R, si_, sub_) do { const int bh_ = (si_) >> 4, j_ = (si_) & 15, b_ = bh_ >> 2, h_ = bh_ & 3, combo_ = (sub_) >> 1, m_ = combo_ >> 1, vh_ = combo_ & 1, qb_ = ((sub_) & 1) ? j_ : 31 - j_;     \
            (R).Q = QH + ((size_t)((b_ * 8 + h_ * 2 + m_) * SEQ + qb_ * 256)) * 128; (R).K = KH + ((size_t)((b_ * 8 + h_ * 2 + m_) * SEQ)) * 128; \
            (R).V = VH + ((size_t)((b_ * 8 + h_ * 2 + vh_) * SEQ)) * 128; (R).O = O16 + ((size_t)((b_ * 16 + h_ * 4 + m_ * 2 + vh_) * SEQ + qb_ * 256)) * 128; (R).P0 = qb_ * 256; } while (0)
            att::BlockRef cur, nxt; MKREF(cur, si, sub);
            att::attn_prime(cur, (char*)lds, S);
            for (;;) {
                int sin = si, subn = sub + 1; bool last = false;
                if (subn == 8) { subn = 0; sin = si + G; if (sin >= NSI) last = true; }
                if (last) nxt = cur; else MKREF(nxt, sin, subn);
                att::attn_block(cur, nxt, (char*)lds, S);
                if (sub == 7) {
                    asm volatile("s_waitcnt vmcnt(0)" ::: "memory"); __syncthreads();
                    float lam;
                    { const float* lq1 = KARG(const float*, 13); const float* lk1 = KARG(const float*, 14); const float* lq2 = KARG(const float*, 15); const float* lk2 = KARG(const float*, 16);
                      lam = __expf(wave_sum(lq1[lane] * lk1[lane] + lq1[lane + 64] * lk1[lane + 64])) - __expf(wave_sum(lq2[lane] * lk2[lane] + lq2[lane + 64] * lk2[lane + 64])) + 0.2f; }
                    const int l16 = lane & 15, rq = lane >> 4;
                    const float* subln_g = KARG(const float*, 17);
                    f32x4 sg[2][2];
#pragma unroll
                    for (int vh = 0; vh < 2; ++vh) { sg[vh][0] = *(const f32x4*)(subln_g + vh * 128 + 8 * l16) * 0.8f; sg[vh][1] = *(const f32x4*)(subln_g + vh * 128 + 8 * l16 + 4) * 0.8f; }
                    const int bh_ = si >> 4, j_ = si & 15, b_ = bh_ >> 2, h_ = bh_ & 3;
                    for (int r0 = wave * 8; r0 < 512; r0 += NWAVES * 8) {
                        v4u uu[2][4];
#pragma unroll
                        for (int q = 0; q < 2; ++q) { const int rr = r0 + q * 4 + rq, s_ = (rr < 256 ? 31 - j_ : j_) * 256 + (rr & 255);
                            const bf16* base = O16 + ((size_t)((b_ * 16 + h_ * 4) * SEQ + s_)) * 128 + 8 * l16;
#pragma unroll
                            for (int c = 0; c < 4; ++c) uu[q][c] = *(const v4u*)(base + (size_t)c * SEQ * 128); }
#pragma unroll
                        for (int q = 0; q < 2; ++q) { const int rr = r0 + q * 4 + rq, s_ = (rr < 256 ? 31 - j_ : j_) * 256 + (rr & 255);
                            float d[2][8]; float ss = 0.f;
#pragma unroll
                            for (int vh = 0; vh < 2; ++vh) { const v4u p = uu[q][vh], n = uu[q][2 + vh];
                                d[vh][0] = pg8::bflo(p.x) - lam * pg8::bflo(n.x); d[vh][1] = pg8::bfhi(p.x) - lam * pg8::bfhi(n.x); d[vh][2] = pg8::bflo(p.y) - lam * pg8::bflo(n.y); d[vh][3] = pg8::bfhi(p.y) - lam * pg8::bfhi(n.y);
                                d[vh][4] = pg8::bflo(p.z) - lam * pg8::bflo(n.z); d[vh][5] = pg8::bfhi(p.z) - lam * pg8::bfhi(n.z); d[vh][6] = pg8::bflo(p.w) - lam * pg8::bflo(n.w); d[vh][7] = pg8::bfhi(p.w) - lam * pg8::bfhi(n.w);
#pragma unroll
                                for (int e = 0; e < 8; ++e) ss += d[vh][e] * d[vh][e]; }
                            ss += __shfl_xor(ss, 1); ss += __shfl_xor(ss, 2); ss += __shfl_xor(ss, 4); ss += __shfl_xor(ss, 8);
                            const float rs = 1.0f / sqrtf(ss * (1.f / 256.f) + EPS);
                            bf16* dst = OA + ((size_t)(b_ * SEQ + s_)) * 1024 + h_ * 256 + 8 * l16;
#pragma unroll
                            for (int vh = 0; vh < 2; ++vh) { v4u o;
                                o.x = pg8::cvt_pk_bf16(d[vh][0] * rs * sg[vh][0].x, d[vh][1] * rs * sg[vh][0].y); o.y = pg8::cvt_pk_bf16(d[vh][2] * rs * sg[vh][0].z, d[vh][3] * rs * sg[vh][0].w);
                                o.z = pg8::cvt_pk_bf16(d[vh][4] * rs * sg[vh][1].x, d[vh][5] * rs * sg[vh][1].y); o.w = pg8::cvt_pk_bf16(d[vh][6] * rs * sg[vh][1].z, d[vh][7] * rs * sg[vh][1].w);
                                *(v4u*)(dst + vh * 128) = o; } }
                    }
                }
                if (last) break;
                cur = nxt; si = sin; sub = subn;
            }
#undef MKREF
        }
    }
    GSYNC(); }
    for (int rep_ = 0; rep_ <= ((DUPM >> 6) & 1); ++rep_) {
    if (PHM & (1 << 6))
    {
        bf16* YC = WSP(WS_YC); bf16* OA = WSP(WS_OA); bf16* WC = WSP(WS_WC); bf16* WA = WSP(WS_WA); bf16* MG = WSP(WS_MG); bf16* GT = WSP(WS_GT);
        pg8::StaticOrder S; S.init(T, DM, G, bx);
        { pg8::Gemm g{YC, WC, T, DM, CW}; pg8::EpiMerge<false> E{MG, GT}; pg8::gemm_phase<pg8::EpiMerge<false>, pg8::StaticOrder, true, true>(L, g, S, E); }
        { pg8::Gemm g{OA, WA, T, DM, CW}; pg8::EpiMerge<true> E{MG, GT + 2048}; pg8::gemm_phase<pg8::EpiMerge<true>, pg8::StaticOrder, true, true>(L, g, S, E); }
    }
    GSYNC(); }
    for (int rep_ = 0; rep_ <= ((DUPM >> 7) & 1); ++rep_) {
    if (PHM & (1 << 7))
    {
        bf16* MG = WSP(WS_MG); bf16* WO = WSP(WS_WO); const float* x = KARG(const float*, 0); float* out = KARG(float*, 24); const float* ADA = (const float*)WSP(WS_ADA);
        pg8::Gemm g{MG, WO, T, DM, DM}; pg8::StaticOrder S; S.init(T, DM, G, bx);
        pg8::EpiRes E{x, out, ADA + 2 * DM};
        pg8::gemm_phase<pg8::EpiRes, pg8::StaticOrder, true, true>(L, g, S, E);
    }
    GSYNC(); }
    for (int rep_ = 0; rep_ <= ((DUPM >> 8) & 1); ++rep_) {
    if (PHM & (1 << 8)) { PHASE_IDS();
    norm_mod_rows(KARG(const float*, 24), KARG(const float*, 21), (const float*)WSP(WS_ADA), 3 * DM, 4 * DM, WSP(WS_XN), gw, NGW, lane); }
    GSYNC(); }
    for (int rep_ = 0; rep_ <= ((DUPM >> 9) & 1); ++rep_) {
    if (PHM & (1 << 9))
    {
        bf16* XN = WSP(WS_XN); bf16* W1 = WSP(WS_W1); bf16* HB = WSP(WS_HB);
        pg8::Gemm g{XN, W1, T, FF, DM}; pg8::StaticOrder S; S.init(T, FF, G, bx, WGM_P9);
        pg8::EpiRelu2 E{HB, FF};
        pg8::gemm_phase<pg8::EpiRelu2, pg8::StaticOrder, true, true>(L, g, S, E);
    }
    GSYNC(); }
    if (PHM & (1 << 10))
    {
        bf16* HB = WSP(WS_HB); bf16* W2 = WSP(WS_W2); float* out = KARG(float*, 24); const float* ADA = (const float*)WSP(WS_ADA);
        pg8::Gemm g{HB, W2, T, DM, FF}; pg8::StaticOrder S; S.init(T, DM, G, bx, pg8::WGM, REV_P10);
        pg8::EpiRes E{out, out, ADA + 5 * DM};
        pg8::gemm_phase<pg8::EpiRes, pg8::StaticOrder, true, true>(L, g, S, E);
    }
}

extern "C" void kernel_launch(void* const* d_in, const int* in_sizes, int n_in, void* d_out, int out_size, void* d_ws, size_t ws_size, hipStream_t stream) {
    static int grid = 0;
    if (grid == 0) {
        if (n_in != 24 || in_sizes[0] != T * DM || out_size != T * DM || ws_size < WS_END) { fprintf(stderr, "kernel_launch: unexpected shapes (n_in %d, in0 %d, out %d, ws %zu)\n", n_in, n_in > 0 ? in_sizes[0] : -1, out_size, ws_size); grid = -1; return; }
        int dev = 0, cus = 0, per_cu = 0;
        (void)hipGetDevice(&dev); (void)hipDeviceGetAttribute(&cus, hipDeviceAttributeMultiprocessorCount, dev);
        if (hipFuncSetAttribute((const void*)mega_fwd, hipFuncAttributeMaxDynamicSharedMemorySize, LDS_BYTES) != hipSuccess) { fprintf(stderr, "kernel_launch: hipFuncSetAttribute failed\n"); grid = -1; return; }
        if (hipOccupancyMaxActiveBlocksPerMultiprocessor(&per_cu, (const void*)mega_fwd, NTHR, LDS_BYTES) != hipSuccess || per_cu < 1) { fprintf(stderr, "kernel_launch: occupancy query says %d\n", per_cu); per_cu = 1; }
        (void)hipGetLastError();
        grid = cus * 1;
        if (grid <= 0) grid = 256;
    }
    if (grid < 0) return;
    if (hipMemsetAsync((char*)d_ws + WS_CTL, 0, CTL_BYTES, stream) != hipSuccess) { fprintf(stderr, "kernel_launch: memset failed\n"); return; }
    Args a{};
    for (int i = 0; i < 24; ++i) a.in[i] = d_in[i];
    a.out = (float*)d_out; a.ws = (unsigned char*)d_ws;
    void* params[] = {&a};
    hipError_t e = hipLaunchCooperativeKernel((const void*)mega_fwd, dim3(grid), dim3(NTHR), params, LDS_BYTES, stream);
    if (e != hipSuccess) fprintf(stderr, "kernel_launch: cooperative launch failed: %s (grid %d)\n", hipGetErrorString(e), grid);
}
```
